# Optimizing an MI355X kernel written in HIP

```python
import jax, jax.numpy as jnp
from jax import lax
import numpy as np

D_MODEL = 1024
BATCH = 8
SEQ = 8192
DEPTH = 1

N_HEADS = 8
QK_NOPE_DIM = 64
QK_ROPE_DIM = 32
V_HEAD_DIM = 64
Q_LORA_RANK = 256
KV_LORA_RANK = 128
ATTN_WIDTH = N_HEADS * V_HEAD_DIM
CONV_WIDTH = 512
CONV_K = 3
N_BRANCH = 2
BRANCH_WIDTH = 512
D_FF = 2816
N_SUB = 3
ROPE_THETA = 10000.0
Q_BLOCK = 128
EPS = 1e-6
IN_COLS = Q_LORA_RANK + KV_LORA_RANK + QK_ROPE_DIM + 3 * CONV_WIDTH + N_BRANCH * D_MODEL

kernel_name = "hybrid_mla_shortconv_macaron_adaln"


def rms_norm(x, w):
    xf = x.astype(jnp.float32)
    y = xf * lax.rsqrt(jnp.mean(xf * xf, axis=-1, keepdims=True) + EPS)
    return (y * w.astype(jnp.float32)).astype(x.dtype)


def modulate(x, w, shift, scale):
    return rms_norm(x, w) * (1 + scale[:, None, :]) + shift[:, None, :]


def swiglu(h, w13, w2):
    gu = jnp.einsum('bsd,df->bsf', h, w13)
    g, u = jnp.split(gu, 2, axis=-1)
    return jnp.einsum('bsf,fd->bsd', jax.nn.silu(g) * u, w2)


def rope_tables(positions):
    inv_freq = 1.0 / (ROPE_THETA ** (jnp.arange(0, QK_ROPE_DIM, 2, dtype=jnp.float32) / QK_ROPE_DIM))
    ang = positions.astype(jnp.float32)[..., None] * inv_freq
    return jnp.cos(ang), jnp.sin(ang)


def apply_rope(x, cos, sin):
    xf = x.astype(jnp.float32)
    x1, x2 = jnp.split(xf, 2, axis=-1)
    return jnp.concatenate([x1 * cos - x2 * sin, x2 * cos + x1 * sin], axis=-1).astype(x.dtype)


def causal_mla_attention(q_nope, q_rope, k_nope, k_rope, v):
    b, s, h, _ = q_nope.shape
    nb = s // Q_BLOCK
    scale = (QK_NOPE_DIM + QK_ROPE_DIM) ** -0.5
    key_idx = jnp.arange(s)

    def to_blocks(t):
        return jnp.moveaxis(t.reshape(b, nb, Q_BLOCK, *t.shape[2:]), 1, 0)

    def block(args):
        qn, qr, i = args
        sc = (jnp.einsum('bqhd,bkhd->bhqk', qn, k_nope, preferred_element_type=jnp.float32)
              + jnp.einsum('bqhr,bkr->bhqk', qr, k_rope, preferred_element_type=jnp.float32))
        q_idx = i * Q_BLOCK + jnp.arange(Q_BLOCK)
        mask = key_idx[None, :] <= q_idx[:, None]
        sc = jnp.where(mask, sc * scale, -jnp.inf)
        p = jax.nn.softmax(sc, axis=-1).astype(v.dtype)
        return jnp.einsum('bhqk,bkhd->bqhd', p, v)

    out = lax.map(block, (to_blocks(q_nope), to_blocks(q_rope), jnp.arange(nb)))
    return jnp.moveaxis(out, 0, 1).reshape(b, s, h * V_HEAD_DIM)


def hybrid_mixer(h, cos, sin, w_in, q_a_norm, w_uq, kv_a_norm, w_ukv,
                 q_norm_nope, k_norm_nope, q_norm_rope, k_norm_rope,
                 conv_w, w_branch, w_out):
    b, s, _ = h.shape
    proj = jnp.einsum('bsd,dn->bsn', h, w_in)
    i1 = Q_LORA_RANK
    i2 = i1 + KV_LORA_RANK
    i3 = i2 + QK_ROPE_DIM
    i4 = i3 + 3 * CONV_WIDTH
    c_q, c_kv, k_rope, conv_in, gate_logits = jnp.split(proj, [i1, i2, i3, i4], axis=-1)

    q = jnp.einsum('bsr,rn->bsn', rms_norm(c_q, q_a_norm), w_uq)
    q = q.reshape(b, s, N_HEADS, QK_NOPE_DIM + QK_ROPE_DIM)
    q_nope, q_rope = q[..., :QK_NOPE_DIM], q[..., QK_NOPE_DIM:]
    kv = jnp.einsum('bsr,rn->bsn', rms_norm(c_kv, kv_a_norm), w_ukv)
    kv = kv.reshape(b, s, N_HEADS, QK_NOPE_DIM + V_HEAD_DIM)
    k_nope, v = kv[..., :QK_NOPE_DIM], kv[..., QK_NOPE_DIM:]
    q_nope = rms_norm(q_nope, q_norm_nope)
    k_nope = rms_norm(k_nope, k_norm_nope)
    q_rope = apply_rope(rms_norm(q_rope, q_norm_rope), cos[:, :, None, :], sin[:, :, None, :])
    k_rope = apply_rope(rms_norm(k_rope, k_norm_rope), cos, sin)
    o_attn = causal_mla_attention(q_nope, q_rope, k_nope, k_rope, v)

    xv, gate_b, gate_c = jnp.split(conv_in, 3, axis=-1)
    u = gate_c * xv
    u = lax.conv_general_dilated(u, conv_w[:, None, :], window_strides=(1,),
                                 padding=[(CONV_K - 1, 0)],
                                 dimension_numbers=('NWC', 'WIO', 'NWC'),
                                 feature_group_count=CONV_WIDTH)
    o_conv = gate_b * u

    branches = jnp.stack([o_attn, o_conv], axis=2)
    y_br = jnp.einsum('bsgk,gkd->bsgd', branches, w_branch)
    gates = jax.nn.sigmoid(gate_logits.reshape(b, s, N_BRANCH, D_MODEL))
    merged = jnp.sum(gates * y_br, axis=2)
    return jnp.einsum('bsd,de->bse', merged, w_out)


def setup_inputs(seed: int = 0) -> dict:
    key = jax.random.key(seed)
    ks = jax.random.split(key, 20)
    f32 = jnp.float32

    def nrm(k, shape, fan_in):
        return jax.random.normal(k, shape, f32) * (fan_in ** -0.5)

    def gain(k, shape):
        return 1.0 + 0.02 * jax.random.normal(k, shape, f32)

    x = jax.random.normal(ks[0], (BATCH, SEQ, D_MODEL), f32)
    c = jax.random.normal(ks[1], (BATCH, D_MODEL), f32)
    offsets = jax.random.randint(ks[2], (BATCH, 1), 0, 1024, dtype=jnp.int32)
    positions = jnp.arange(SEQ, dtype=jnp.int32)[None, :] + offsets
    return {
        "x": x,
        "c": c,
        "positions": positions,
        "w_ada": nrm(ks[3], (DEPTH, D_MODEL, 3 * N_SUB * D_MODEL), D_MODEL),
        "b_ada": 0.01 * jax.random.normal(ks[4], (DEPTH, 3 * N_SUB * D_MODEL), f32),
        "norm_w": gain(ks[5], (DEPTH, N_SUB, D_MODEL)),
        "ffn_w13": nrm(ks[6], (DEPTH, 2, D_MODEL, 2 * D_FF), D_MODEL),
        "ffn_w2": nrm(ks[7], (DEPTH, 2, D_FF, D_MODEL), D_FF),
        "w_in": nrm(ks[8], (DEPTH, D_MODEL, IN_COLS), D_MODEL),
        "q_a_norm": gain(ks[9], (DEPTH, Q_LORA_RANK)),
        "w_uq": nrm(ks[10], (DEPTH, Q_LORA_RANK, N_HEADS * (QK_NOPE_DIM + QK_ROPE_DIM)), Q_LORA_RANK),
        "kv_a_norm": gain(ks[11], (DEPTH, KV_LORA_RANK)),
        "w_ukv": nrm(ks[12], (DEPTH, KV_LORA_RANK, N_HEADS * (QK_NOPE_DIM + V_HEAD_DIM)), KV_LORA_RANK),
        "q_norm_nope": gain(ks[13], (DEPTH, QK_NOPE_DIM)),
        "k_norm_nope": gain(ks[14], (DEPTH, QK_NOPE_DIM)),
        "q_norm_rope": gain(ks[15], (DEPTH, QK_ROPE_DIM)),
        "k_norm_rope": gain(ks[16], (DEPTH, QK_ROPE_DIM)),
        "conv_w": nrm(ks[17], (DEPTH, CONV_K, CONV_WIDTH), CONV_K),
        "w_branch": nrm(ks[18], (DEPTH, N_BRANCH, BRANCH_WIDTH, D_MODEL), BRANCH_WIDTH),
        "w_out": nrm(ks[19], (DEPTH, D_MODEL, D_MODEL), D_MODEL),
    }


def reference(x, c, positions, w_ada, b_ada, norm_w, ffn_w13, ffn_w2, w_in,
              q_a_norm, w_uq, kv_a_norm, w_ukv, q_norm_nope, k_norm_nope,
              q_norm_rope, k_norm_rope, conv_w, w_branch, w_out):
    b = x.shape[0]
    cos, sin = rope_tables(positions)
    c_act = jax.nn.silu(c)
    for l in range(DEPTH):
        mod = (jnp.einsum('bd,dn->bn', c_act, w_ada[l]) + b_ada[l]).reshape(b, N_SUB, 3, D_MODEL)
        h = modulate(x, norm_w[l, 0], mod[:, 0, 0], mod[:, 0, 1])
        x = x + 0.5 * mod[:, 0, 2][:, None, :] * swiglu(h, ffn_w13[l, 0], ffn_w2[l, 0])
        h = modulate(x, norm_w[l, 1], mod[:, 1, 0], mod[:, 1, 1])
        y = hybrid_mixer(h, cos, sin, w_in[l], q_a_norm[l], w_uq[l], kv_a_norm[l], w_ukv[l],
                         q_norm_nope[l], k_norm_nope[l], q_norm_rope[l], k_norm_rope[l],
                         conv_w[l], w_branch[l], w_out[l])
        x = x + mod[:, 1, 2][:, None, :] * y
        h = modulate(x, norm_w[l, 2], mod[:, 2, 0], mod[:, 2, 1])
        x = x + 0.5 * mod[:, 2, 2][:, None, :] * swiglu(h, ffn_w13[l, 1], ffn_w2[l, 1])
    return x
```

```cpp
#include <hip/hip_runtime.h>
#include <hip/hip_cooperative_groups.h>
#include <cstdio>
#include <cstdint>
namespace cg = cooperative_groups;

#define LAS __attribute__((address_space(3)))
#define GAS __attribute__((address_space(1)))
typedef unsigned short bf16_t;
typedef short bf16x8 __attribute__((ext_vector_type(8)));
typedef float f32x4 __attribute__((ext_vector_type(4)));
typedef float f32x16 __attribute__((ext_vector_type(16)));
typedef unsigned u32x4 __attribute__((ext_vector_type(4)));
typedef unsigned u32x2 __attribute__((ext_vector_type(2)));

constexpr int BATCH = 8, SEQ = 8192, T = BATCH * SEQ, DM = 1024, FF = 2816, NH = 8;
constexpr int QLD = 768, PROJ_LD = 4096, MODLD = 9216;
constexpr int C_CONV = 416, C_GB = 928, C_GC = 1440, C_GL = 1952;
constexpr float EPS = 1e-6f;
constexpr float QSCALE = 0.10206207261596577f * 1.4426950408889634f;

constexpr size_t MiB = 1u << 20;
constexpr size_t WS_MOD = 0, WS_RSTDQ = 1 * MiB, WS_RSTDKV = 1 * MiB + 512 * 1024, WS_COS = 2 * MiB, WS_SIN = 6 * MiB, WS_KR = 10 * MiB;
constexpr size_t WS_W13A = 16 * MiB, WS_W13B = 27 * MiB, WS_W2A = 38 * MiB, WS_W2B = 38 * MiB + 5632 * 1024, WS_WIN = 49 * MiB;
constexpr size_t WS_WUQ = 57 * MiB, WS_WUK = 57 * MiB + 512 * 1024, WS_WV = 57 * MiB + 768 * 1024, WS_WB0 = 58 * MiB, WS_WB1 = 59 * MiB, WS_WOUT = 60 * MiB;
constexpr size_t WS_H = 64 * MiB, WS_OATT = 64 * MiB, WS_OCONV = 128 * MiB;
constexpr size_t WS_BIG = 192 * MiB;
constexpr size_t WS_Q = 704 * MiB, WS_KN = 800 * MiB, WS_MERGED = 704 * MiB, WS_VT = 864 * MiB, WS_SSP = 928 * MiB, WS_END = 932 * MiB;
constexpr size_t WS_SHW0 = 14 * MiB, WS_SHW1 = 14 * MiB + 256 * 1024, WS_SHW2 = 14 * MiB + 512 * 1024, WS_AVEC = 14 * MiB + 768 * 1024;
constexpr size_t WS_X2B = 544 * MiB;

constexpr size_t WS_BAR = 15 * MiB, BAR_BYTES = 16384;
constexpr int LDS_BYTES = 147456, LDS_MISC = 131072 + 320;

template <class P> __device__ __forceinline__ P* opq(P* p) { asm volatile("" : "+s"(p)); return p; }
__device__ __forceinline__ int opq_tid() { int t = threadIdx.x; asm volatile("" : "+v"(t)); return t; }
__device__ __forceinline__ unsigned cvt_pk_bf16(float lo, float hi) { unsigned r; asm("v_cvt_pk_bf16_f32 %0, %1, %2" : "=v"(r) : "v"(lo), "v"(hi)); return r; }
__device__ __forceinline__ float bf_lo(unsigned w) { return __uint_as_float(w << 16); }
__device__ __forceinline__ float bf_hi(unsigned w) { return __uint_as_float(w & 0xffff0000u); }
__device__ __forceinline__ float fast_sigmoid(float x) { return __builtin_amdgcn_rcpf(1.0f + __expf(-x)); }
__device__ __forceinline__ u32x4 pack8(f32x4 a, f32x4 b) { u32x4 w; w.x = cvt_pk_bf16(a[0], a[1]); w.y = cvt_pk_bf16(a[2], a[3]); w.z = cvt_pk_bf16(b[0], b[1]); w.w = cvt_pk_bf16(b[2], b[3]); return w; }
__device__ __forceinline__ float wave_sum(float v) {
#pragma unroll
    for (int o = 1; o < 64; o <<= 1) v += __shfl_xor(v, o);
    return v;
}

namespace pg8 {
constexpr int BM = 256, BK = 64, HALF = 128, HTB = HALF * BK * 2, STAGE_BYTES = 8 * HTB, NXCD = 8, WGM = 8;
__host__ __device__ __forceinline__ int lds_byte(int r, int c) { const int st = (r >> 4) * 2 + (c >> 5), rr = r & 15, cc = c & 31, ob = rr * 64 + cc * 2; return st * 1024 + (ob ^ (((ob >> 9) & 1) << 5)); }
__host__ __device__ __forceinline__ void stage_rc(int b, int& R, int& C) { const int st = b / 1024, sb = b % 1024, swz = sb ^ (((sb >> 9) & 1) << 5); R = (st >> 1) * 16 + swz / 64; C = (st & 1) * 32 + (swz % 64) / 2; }
__host__ __device__ __forceinline__ int perm32(int rho) { const int n = rho >> 4, i = rho & 15; return 8 * (i >> 2) + 4 * n + (i & 3); }

struct Unit { int pm, pn; };
struct Gemm { const bf16_t* A; const bf16_t* Bt; int M, N, K, lda, ldb; };

struct StaticOrder {
    int nM, nN, nwg, G, c;
    __host__ __device__ void init(int M, int N, int G_, int c_) { nM = M / BM; nN = N / BM; nwg = nM * nN; G = G_; c = c_; }
    __host__ __device__ bool next(int i, Unit& u) const {
        const long L = (long)i * G + c; if (L >= nwg) return false;
        int wgid = (int)L; { const int q = nwg / NXCD, r = nwg % NXCD, xcd = wgid % NXCD, off = wgid / NXCD; wgid = (xcd < r ? xcd * (q + 1) : r * (q + 1) + (xcd - r) * q) + off; }
        const int nig = WGM * nN, gid = wgid / nig, fm = gid * WGM, gsz = (nM - fm) < WGM ? (nM - fm) : WGM;
        u.pm = fm + ((wgid % nig) % gsz); u.pn = (wgid % nig) / gsz; return true;
    }
};

template <class Epi, class Sched, bool ALIGN_EPI>
__device__ __forceinline__ void gemm_phase(LAS unsigned char* lds, const Gemm g, const Sched& S, const Epi& E) {
    int tid_ = threadIdx.x; asm volatile("" : "+v"(tid_));
    const int tid = tid_, wid = __builtin_amdgcn_readfirstlane(tid >> 6), lane = tid & 63, wr = wid >> 2, wc = wid & 3, fr = lane & 15, fq = lane >> 4;
    const int K = g.K, nt = K / BK;
    unsigned voffA[2], voffB[2];
#pragma unroll
    for (int i = 0; i < 2; ++i) { int R, C; stage_rc(tid * 16 + i * 8192, R, C); const int Rb = Epi::PERM ? ((R & ~31) + perm32(R & 31)) : R;
        voffA[i] = (unsigned)(R * g.lda + C) * 2u; voffB[i] = (unsigned)(Rb * g.ldb + C) * 2u; }
    const size_t kstep = (size_t)(BK * 2);
    const size_t hstepA = (size_t)HALF * g.lda * 2, hstepB = (size_t)HALF * g.ldb * 2;
    const size_t tstepA = 2 * hstepA, tstepB = 2 * hstepB;
    const unsigned ldsw = (unsigned)wid * 1024u;
    const int aoff = lds_byte(wr * 64 + fr, fq * 8), boff = lds_byte(wc * 32 + fr, fq * 8);
#define PG8_SA(b, h) (((b) * 2 + (h)) * HTB)
#define PG8_SB(b, h) ((4 + (b) * 2 + (h)) * HTB)
#define PG8_STAGE(bufoff, gbase, voff) do { _Pragma("unroll") for (int _i = 0; _i < 2; ++_i) \
        __builtin_amdgcn_global_load_lds((const unsigned*)((const char*)(gbase) + (voff)[_i]), (LAS unsigned*)(lds + (bufoff) + ldsw + _i * 8192), 16, 0, 0); } while (0)
#define PG8_LDA(dst, b, h) do { _Pragma("unroll") for (int m = 0; m < 4; ++m) _Pragma("unroll") for (int k = 0; k < 2; ++k) dst[m][k] = *(const LAS bf16x8*)(lds + PG8_SA(b, h) + aoff + m * 2048 + k * 1024); } while (0)
#define PG8_LDB(dst, b, h) do { _Pragma("unroll") for (int n = 0; n < 2; ++n) _Pragma("unroll") for (int k = 0; k < 2; ++k) dst[n][k] = *(const LAS bf16x8*)(lds + PG8_SB(b, h) + boff + n * 2048 + k * 1024); } while (0)
#define PG8_MMA(ai, bj, At, Bt) do { __builtin_amdgcn_s_setprio(1); _Pragma("unroll") for (int m = 0; m < 4; ++m) _Pragma("unroll") for (int n = 0; n < 2; ++n) _Pragma("unroll") for (int k = 0; k < 2; ++k) \
        acc[ai][bj][m][n] = __builtin_amdgcn_mfma_f32_16x16x32_bf16(Bt[n][k], At[m][k], acc[ai][bj][m][n], 0, 0, 0); __builtin_amdgcn_s_setprio(0); } while (0)
#define PG8_WAIT_V(n) asm volatile("s_waitcnt vmcnt(" #n ")" ::: "memory")
#define PG8_WAIT_L(n) asm volatile("s_waitcnt lgkmcnt(" #n ")" ::: "memory")
#define PG8_BAR __builtin_amdgcn_s_barrier()
#define PG8_SCHED __builtin_amdgcn_sched_barrier(0)
    Unit cur, nxt; int ui = 0;
    if (!S.next(0, cur)) return;
    f32x4 acc[2][2][4][2];
#pragma unroll
    for (int a = 0; a < 2; ++a)
#pragma unroll
        for (int b = 0; b < 2; ++b)
#pragma unroll
            for (int m = 0; m < 4; ++m)
#pragma unroll
                for (int n = 0; n < 2; ++n) acc[a][b][m][n] = (f32x4){0.f, 0.f, 0.f, 0.f};
    bf16x8 At[4][2], B0[2][2], B1[2][2];
    const char* cA = (const char*)g.A + (size_t)cur.pm * tstepA; const char* cB = (const char*)g.Bt + (size_t)cur.pn * tstepB;
    PG8_STAGE(PG8_SB(0, 0), cB, voffB); PG8_STAGE(PG8_SB(0, 1), cB + hstepB, voffB); PG8_STAGE(PG8_SA(0, 0), cA, voffA); PG8_STAGE(PG8_SA(0, 1), cA + hstepA, voffA);
    if (wr == 1) PG8_BAR;
    PG8_WAIT_V(2); PG8_BAR;
    PG8_STAGE(PG8_SB(1, 0), cB + kstep, voffB); PG8_STAGE(PG8_SA(1, 0), cA + kstep, voffA); PG8_STAGE(PG8_SB(1, 1), cB + hstepB + kstep, voffB);
    PG8_WAIT_V(6); PG8_BAR;
    for (;;) {
        const bool has_next = S.next(ui + 1, nxt);
        const char* nA = has_next ? (const char*)g.A + (size_t)nxt.pm * tstepA : cA; const char* nB = has_next ? (const char*)g.Bt + (size_t)nxt.pn * tstepB : cB;
        for (int t = 0; t < nt; t += 2) {
            const bool last = (t == nt - 2);
            const char* a1 = cA + (size_t)(t + 1) * kstep;
            const char* a2 = last ? nA : cA + (size_t)(t + 2) * kstep; const char* b2 = last ? nB : cB + (size_t)(t + 2) * kstep;
            const char* a3 = a2 + kstep; const char* b3 = b2 + kstep;
            PG8_LDB(B0, 0, 0); PG8_LDB(B1, 0, 1); PG8_SCHED; PG8_LDA(At, 0, 0); PG8_STAGE(PG8_SA(1, 1), a1 + hstepA, voffA);
            PG8_WAIT_V(8); PG8_WAIT_L(0); PG8_BAR; PG8_MMA(0, 0, At, B0); PG8_MMA(0, 1, At, B1); PG8_BAR; PG8_SCHED;
            PG8_LDA(At, 0, 1); PG8_STAGE(PG8_SB(0, 0), b2, voffB); PG8_STAGE(PG8_SB(0, 1), b2 + hstepB, voffB); PG8_STAGE(PG8_SA(0, 0), a2, voffA);
            PG8_WAIT_V(8); PG8_WAIT_L(0); PG8_BAR; PG8_MMA(1, 0, At, B0); PG8_MMA(1, 1, At, B1); PG8_BAR; PG8_SCHED;
            PG8_LDB(B0, 1, 0); PG8_LDB(B1, 1, 1); PG8_SCHED; PG8_LDA(At, 1, 0); PG8_STAGE(PG8_SA(0, 1), a2 + hstepA, voffA);
            PG8_WAIT_V(8); PG8_WAIT_L(0); PG8_BAR; PG8_MMA(0, 0, At, B0); PG8_MMA(0, 1, At, B1); PG8_BAR; PG8_SCHED;
            PG8_LDA(At, 1, 1); PG8_STAGE(PG8_SB(1, 0), b3, voffB); PG8_STAGE(PG8_SB(1, 1), b3 + hstepB, voffB); PG8_STAGE(PG8_SA(1, 0), a3, voffA);
            PG8_WAIT_V(8); PG8_WAIT_L(0); PG8_BAR; PG8_MMA(1, 0, At, B0); PG8_MMA(1, 1, At, B1); PG8_BAR; PG8_SCHED;
        }
        if constexpr (ALIGN_EPI) { if (wr == 0) PG8_BAR; }
        { int fr_ = fr, fq_ = fq; asm volatile("" : "+v"(fr_), "+v"(fq_)); E(acc, cur, wr, wc, fr_, fq_); }
        if (!has_next) break;
#pragma unroll
        for (int a = 0; a < 2; ++a)
#pragma unroll
            for (int b = 0; b < 2; ++b)
#pragma unroll
                for (int m = 0; m < 4; ++m)
#pragma unroll
                    for (int n = 0; n < 2; ++n) acc[a][b][m][n] = (f32x4){0.f, 0.f, 0.f, 0.f};
        cur = nxt; cA = nA; cB = nB; ++ui;
        if constexpr (ALIGN_EPI) { if (wr == 1) PG8_BAR; }
    }
    PG8_WAIT_V(0);
    if constexpr (!ALIGN_EPI) { if (wr == 0) PG8_BAR; }
    PG8_BAR;
#undef PG8_SA
#undef PG8_SB
#undef PG8_STAGE
#undef PG8_LDA
#undef PG8_LDB
#undef PG8_MMA
#undef PG8_WAIT_V
#undef PG8_WAIT_L
#undef PG8_BAR
#undef PG8_SCHED
}

typedef f32x4 Acc[2][2][4][2];

struct EpiStoreBf16 { static constexpr bool PERM = true; bf16_t* O; int ldc;
    __device__ __forceinline__ void operator()(const Acc& acc, const Unit& u, int wr, int wc, int fr, int fq) const {
        const int row0 = u.pm * BM + wr * 64 + fr, col0 = u.pn * BM + wc * 32 + 8 * fq;
#pragma unroll
        for (int ai = 0; ai < 2; ++ai)
#pragma unroll
            for (int m = 0; m < 4; ++m) { bf16_t* rowp = O + (size_t)(row0 + ai * HALF + m * 16) * ldc + col0;
#pragma unroll
                for (int bj = 0; bj < 2; ++bj) *(GAS u32x4*)(rowp + bj * HALF) = pack8(acc[ai][bj][m][0], acc[ai][bj][m][1]); }
    }
};
__device__ __forceinline__ void rstd8_from_ssp(const float* ssp, int row0, int fq, float (&rs)[2][4]) {
    f32x4 p[2][4];
#pragma unroll
    for (int ai = 0; ai < 2; ++ai)
#pragma unroll
        for (int m = 0; m < 4; ++m) p[ai][m] = *(const GAS f32x4*)(ssp + (size_t)(row0 + ai * 128 + m * 16) * 16 + 4 * fq);
#pragma unroll
    for (int ai = 0; ai < 2; ++ai)
#pragma unroll
        for (int m = 0; m < 4; ++m) { float v = (p[ai][m][0] + p[ai][m][1]) + (p[ai][m][2] + p[ai][m][3]); v += __shfl_xor(v, 16); v += __shfl_xor(v, 32); rs[ai][m] = rsqrtf(v * (1.0f / DM) + EPS); }
}
struct EpiSwiGLU { static constexpr bool PERM = true; bf16_t* O; const float* ssp; const float* shw;
    __device__ __forceinline__ void operator()(const Acc& acc, const Unit& u, int wr, int wc, int fr, int fq) const {
        const int row0 = u.pm * BM + wr * 64 + fr, col0 = u.pn * HALF + wc * 32 + 8 * fq, b = u.pm >> 5;
        f32x4 sg[2], su[2];
#pragma unroll
        for (int n = 0; n < 2; ++n) { sg[n] = *(const GAS f32x4*)(shw + (size_t)b * (2 * FF) + col0 + 4 * n); su[n] = *(const GAS f32x4*)(shw + (size_t)b * (2 * FF) + FF + col0 + 4 * n); }
        float rs8[2][4]; rstd8_from_ssp(ssp, row0, fq, rs8);
#pragma unroll
        for (int ai = 0; ai < 2; ++ai)
#pragma unroll
            for (int m = 0; m < 4; ++m) { const int row = row0 + ai * HALF + m * 16; const float rs = rs8[ai][m];
                bf16_t* rowp = O + (size_t)row * FF + col0;
                f32x4 o[2];
#pragma unroll
                for (int n = 0; n < 2; ++n)
#pragma unroll
                    for (int e = 0; e < 4; ++e) { const float gg = acc[ai][0][m][n][e] * rs + sg[n][e], uu = acc[ai][1][m][n][e] * rs + su[n][e]; o[n][e] = gg * fast_sigmoid(gg) * uu; }
                *(GAS u32x4*)rowp = pack8(o[0], o[1]);
                asm volatile("" ::: "memory"); }
    }
};
struct EpiProj { static constexpr bool PERM = true; bf16_t* O; const float* ssp; const float* shw;
    __device__ __forceinline__ void operator()(const Acc& acc, const Unit& u, int wr, int wc, int fr, int fq) const {
        const int row0 = u.pm * BM + wr * 64 + fr, col0 = u.pn * BM + wc * 32 + 8 * fq, b = u.pm >> 5;
        float rs8[2][4]; rstd8_from_ssp(ssp, row0, fq, rs8);
#pragma unroll
        for (int ai = 0; ai < 2; ++ai)
#pragma unroll
            for (int m = 0; m < 4; ++m) { const int row = row0 + ai * HALF + m * 16; const float rs = rs8[ai][m];
                bf16_t* rowp = O + (size_t)row * PROJ_LD + col0;
#pragma unroll
                for (int bj = 0; bj < 2; ++bj) { const f32x4 h0 = *(const GAS f32x4*)(shw + (size_t)b * PROJ_LD + col0 + bj * HALF), h1 = *(const GAS f32x4*)(shw + (size_t)b * PROJ_LD + col0 + bj * HALF + 4);
                    *(GAS u32x4*)(rowp + bj * HALF) = pack8(acc[ai][bj][m][0] * rs + h0, acc[ai][bj][m][1] * rs + h1); }
                asm volatile("" ::: "memory"); }
    }
};
template <int MODE> struct EpiResidN { static constexpr bool PERM = true; const void* base; void* xout; bf16_t* xa; float* ssp; const float* gate; const float* avec; float s;
    __device__ __forceinline__ void operator()(const Acc& acc, const Unit& u, int wr, int wc, int fr, int fq) const {
        const int row0 = u.pm * BM + wr * 64 + fr, col0 = u.pn * BM + wc * 32 + 8 * fq, b = u.pm >> 5;
        float ss[2][4];
#pragma unroll
        for (int ai = 0; ai < 2; ++ai)
#pragma unroll
            for (int m = 0; m < 4; ++m) ss[ai][m] = 0.f;
#pragma unroll
        for (int bj = 0; bj < 2; ++bj) { const int c = col0 + bj * HALF;
            const f32x4 g0 = *(const GAS f32x4*)(gate + (size_t)b * MODLD + c) * s, g1 = *(const GAS f32x4*)(gate + (size_t)b * MODLD + c + 4) * s;
            f32x4 a0 = {0.f, 0.f, 0.f, 0.f}, a1 = {0.f, 0.f, 0.f, 0.f};
            if (MODE < 2) { a0 = *(const GAS f32x4*)(avec + (size_t)b * DM + c); a1 = *(const GAS f32x4*)(avec + (size_t)b * DM + c + 4); }
            constexpr int NB = MODE == 0 ? 2 : 4;
#pragma unroll
            for (int r0 = 0; r0 < 8; r0 += NB) {
                f32x4 bf[NB][2]; u32x4 bw[NB];
#pragma unroll
                for (int q = 0; q < NB; ++q) { const int ai = (r0 + q) >> 2, m = (r0 + q) & 3; const size_t off = (size_t)(row0 + ai * HALF + m * 16) * DM + c;
                    if (MODE == 0) { bf[q][0] = *(const GAS f32x4*)((const float*)base + off); bf[q][1] = *(const GAS f32x4*)((const float*)base + off + 4); }
                    else bw[q] = *(const GAS u32x4*)((const bf16_t*)base + off); }
#pragma unroll
                for (int q = 0; q < NB; ++q) { const int ai = (r0 + q) >> 2, m = (r0 + q) & 3; const size_t off = (size_t)(row0 + ai * HALF + m * 16) * DM + c;
                    f32x4 b0, b1;
                    if (MODE == 0) { b0 = bf[q][0]; b1 = bf[q][1]; }
                    else { const u32x4 w = bw[q]; b0 = (f32x4){bf_lo(w.x), bf_hi(w.x), bf_lo(w.y), bf_hi(w.y)}; b1 = (f32x4){bf_lo(w.z), bf_hi(w.z), bf_lo(w.w), bf_hi(w.w)}; }
                    const f32x4 o0 = b0 + g0 * acc[ai][bj][m][0], o1 = b1 + g1 * acc[ai][bj][m][1];
                    if (MODE == 2) { *(GAS f32x4*)((float*)xout + off) = o0; *(GAS f32x4*)((float*)xout + off + 4) = o1; }
                    else { *(GAS u32x4*)((bf16_t*)xout + off) = pack8(o0, o1); *(GAS u32x4*)(xa + off) = pack8(o0 * a0, o1 * a1);
                        const f32x4 q0 = o0 * o0, q1 = o1 * o1; ss[ai][m] += ((q0[0] + q0[1]) + (q0[2] + q0[3])) + ((q1[0] + q1[1]) + (q1[2] + q1[3])); } }
                asm volatile("" ::: "memory");
            }
        }
        if (MODE < 2) {
#pragma unroll
            for (int ai = 0; ai < 2; ++ai)
#pragma unroll
                for (int m = 0; m < 4; ++m) { float v = ss[ai][m]; v += __shfl_xor(v, 16); v += __shfl_xor(v, 32);
                    if (fq == 0) ((GAS float*)ssp)[(size_t)(row0 + ai * HALF + m * 16) * 16 + u.pn * 4 + wc] = v; }
        }
    }
};
struct EpiVT { static constexpr bool PERM = true; bf16_t* O; const float* rstd;
    __device__ __forceinline__ void operator()(const Acc& acc, const Unit& u, int wr, int wc, int fr, int fq) const {
        const int row0 = u.pm * BM + wr * 64 + fr, col0 = u.pn * BM + wc * 32 + 8 * fq;
#pragma unroll
        for (int ai = 0; ai < 2; ++ai)
#pragma unroll
            for (int m = 0; m < 4; ++m) { bf16_t* rowp = O + (size_t)(row0 + ai * HALF + m * 16) * T + col0;
#pragma unroll
                for (int bj = 0; bj < 2; ++bj) *(GAS u32x4*)(rowp + bj * HALF) = pack8(acc[ai][bj][m][0], acc[ai][bj][m][1]); }
    }
};
template <int ROPE_TILE> struct EpiQK { static constexpr bool PERM = true; bf16_t* O; int ldo, hw; const float* rstd; const float* wn; const float* wrp; const float* cosT; const float* sinT; float c2;
    __device__ __forceinline__ void operator()(const Acc& acc, const Unit& u, int wr, int wc, int fr, int fq) const {
        const int row0 = u.pm * BM + wr * 64 + fr;
        const float* wn = this->wn; const float* wrp = this->wrp;
        asm volatile("" : "+s"(wn), "+s"(wrp));
        if (ROPE_TILE < 0 || u.pn != ROPE_TILE) {
            const int head = 4 * u.pn + wc;
#pragma unroll
            for (int ai = 0; ai < 2; ++ai)
#pragma unroll
                for (int m = 0; m < 4; ++m) { const int row = row0 + ai * HALF + m * 16; const float rs = 1.0f;
                    float ss = 0.f;
#pragma unroll
                    for (int bj = 0; bj < 2; ++bj)
#pragma unroll
                        for (int n = 0; n < 2; ++n) { const f32x4 q = acc[ai][bj][m][n] * acc[ai][bj][m][n]; ss += (q[0] + q[1]) + (q[2] + q[3]); }
                    ss += __shfl_xor(ss, 16); ss += __shfl_xor(ss, 32);
                    const float f = rs * rsqrtf(ss * rs * rs * (1.0f / 64.0f) + EPS) * c2;
                    bf16_t* rowp = O + (size_t)row * ldo + head * hw + 8 * fq;
#pragma unroll
                    for (int bj = 0; bj < 2; ++bj) { const f32x4 w0 = *(const GAS f32x4*)(wn + 32 * bj + 8 * fq), w1 = *(const GAS f32x4*)(wn + 32 * bj + 8 * fq + 4);
                        *(GAS u32x4*)(rowp + 32 * bj) = pack8(acc[ai][bj][m][0] * f * w0, acc[ai][bj][m][1] * f * w1); }
                    asm volatile("" ::: "memory"); }
        } else {
            const float sgn = (fq < 2) ? -1.0f : 1.0f;
#pragma unroll
            for (int ai = 0; ai < 2; ++ai)
#pragma unroll
                for (int m = 0; m < 4; ++m) { const int row = row0 + ai * HALF + m * 16; const float rs = 1.0f;
#pragma unroll
                    for (int bj = 0; bj < 2; ++bj) { float ss = 0.f;
#pragma unroll
                        for (int n = 0; n < 2; ++n) { const f32x4 q = acc[ai][bj][m][n] * acc[ai][bj][m][n]; ss += (q[0] + q[1]) + (q[2] + q[3]); }
                        ss += __shfl_xor(ss, 16); ss += __shfl_xor(ss, 32);
                        const float f = rs * rsqrtf(ss * rs * rs * (1.0f / 32.0f) + EPS);
#pragma unroll
                        for (int n = 0; n < 2; ++n) { const f32x4 w = *(const GAS f32x4*)(wrp + 8 * fq + 4 * n);
                            const f32x4 cs = *(const GAS f32x4*)(cosT + (size_t)row * 16 + 8 * (fq & 1) + 4 * n), sn = *(const GAS f32x4*)(sinT + (size_t)row * 16 + 8 * (fq & 1) + 4 * n);
                            f32x4 o;
#pragma unroll
                            for (int e = 0; e < 4; ++e) { const float y = acc[ai][bj][m][n][e] * f * w[e]; const float pt = __shfl_xor(y, 32); o[e] = (y * cs[e] + sgn * pt * sn[e]) * c2; }
                            *(GAS u32x2*)(O + (size_t)row * ldo + (4 * bj + wc) * hw + 64 + 8 * fq + 4 * n) = (u32x2){cvt_pk_bf16(o[0], o[1]), cvt_pk_bf16(o[2], o[3])}; } }
                    asm volatile("" ::: "memory"); }
        }
    }
};
template <bool FIRST> struct EpiBranch { static constexpr bool PERM = true; bf16_t* O; const bf16_t* GL;
    __device__ __forceinline__ void operator()(const Acc& acc, const Unit& u, int wr, int wc, int fr, int fq) const {
        const int row0 = u.pm * BM + wr * 64 + fr, col0 = u.pn * BM + wc * 32 + 8 * fq;
#pragma unroll
        for (int ai = 0; ai < 2; ++ai)
#pragma unroll
            for (int m = 0; m < 4; ++m) { const size_t row = (size_t)(row0 + ai * HALF + m * 16);
#pragma unroll
                for (int bj = 0; bj < 2; ++bj) { const int c = col0 + bj * HALF;
                    const u32x4 gw = *(const GAS u32x4*)(GL + row * PROJ_LD + c);
                    f32x4 g0 = {bf_lo(gw.x), bf_hi(gw.x), bf_lo(gw.y), bf_hi(gw.y)}, g1 = {bf_lo(gw.z), bf_hi(gw.z), bf_lo(gw.w), bf_hi(gw.w)};
                    f32x4 o0, o1;
#pragma unroll
                    for (int e = 0; e < 4; ++e) { o0[e] = fast_sigmoid(g0[e]) * acc[ai][bj][m][0][e]; o1[e] = fast_sigmoid(g1[e]) * acc[ai][bj][m][1][e]; }
                    bf16_t* op = O + row * DM + c;
                    if (!FIRST) { const u32x4 ow = *(const GAS u32x4*)op;
                        o0 += (f32x4){bf_lo(ow.x), bf_hi(ow.x), bf_lo(ow.y), bf_hi(ow.y)}; o1 += (f32x4){bf_lo(ow.z), bf_hi(ow.z), bf_lo(ow.w), bf_hi(ow.w)}; }
                    *(GAS u32x4*)op = pack8(o0, o1); } }
    }
};
}

namespace att {
constexpr int KROW = 208, VROW = 144, KBUF = 64 * KROW, VBUF = 64 * VROW, V_OFF = 2 * KBUF;
constexpr float THR = 8.0f;
#define ATT_SB() __builtin_amdgcn_sched_barrier(0)
#define ATT_E(i) ((i) < 16 ? e0[(i) & 15] : e1[(i) & 15])
__device__ __forceinline__ float rowmax32(const f32x16& a, const f32x16& b) {
    float x = fmaxf(fmaxf(a[0], a[1]), b[0]), y = fmaxf(fmaxf(a[2], a[3]), b[1]); x = fmaxf(fmaxf(x, b[2]), b[3]);
#pragma unroll
    for (int r = 4; r < 16; r += 4) { x = fmaxf(fmaxf(x, a[r]), a[r + 1]); y = fmaxf(fmaxf(y, a[r + 2]), a[r + 3]); x = fmaxf(fmaxf(x, b[r]), b[r + 1]); y = fmaxf(fmaxf(y, b[r + 2]), b[r + 3]); }
    return fmaxf(x, y);
}
__device__ __forceinline__ void cmask(f32x16& p0, f32x16& p1, int kv0, int qidx, int hi) {
#pragma unroll
    for (int r = 0; r < 16; ++r) { const int kv = kv0 + (r & 3) + 8 * (r >> 2) + 4 * hi; if (kv > qidx) p0[r] = -INFINITY; if (kv + 32 > qidx) p1[r] = -INFINITY; }
}
template <int P> __device__ __forceinline__ void tile_iter(LAS unsigned char* lds, const int jt, const int NT, const int jmax, const int q0, const int qidx, const int hi,
        const unsigned ka, const unsigned va, const bf16_t* kn_src, const bf16_t* kr_src, const bf16_t* vt_src, const unsigned kn_dst, const unsigned kr_dst, const unsigned vt_dst, const bool has_r,
        const bf16x8 (&qr)[6], f32x16& o0, f32x16& o1, f32x16& negm, f32x16& s0, f32x16& s1, f32x16& e0, f32x16& e1, float& m_run, float& l_run,
        u32x4 (&gK)[2], u32x4 (&gR)[2], u32x4 (&gV)[2]) {
        { const int tk = (jt + 3 < NT) ? jt + 3 : NT - 1, tv = (jt + 2 < NT) ? jt + 2 : NT - 1;
          gK[1 - P] = *(const GAS u32x4*)(kn_src + (size_t)tk * 64 * 512); gR[1 - P] = *(const GAS u32x4*)(kr_src + (size_t)tk * 64 * 32); gV[1 - P] = *(const GAS u32x4*)(vt_src + (size_t)tv * 64); }
        if (jt <= jmax) {
            const bool nx = jt + 1 <= jmax;
            const unsigned kb = ((jt + 1) & 1) * KBUF + ka, vb = (jt & 1) * VBUF + va;
            u32x4 pf[4]; float sacc = 0.f;
            {
                bf16x8 kf0 = *(const LAS bf16x8*)(lds + kb), kf1 = *(const LAS bf16x8*)(lds + kb + 32 * KROW), kn0 = kf0, kn1 = kf1;
#pragma unroll
                for (int ks = 0; ks < 6; ++ks) {
                    if (ks < 5) { kn0 = *(const LAS bf16x8*)(lds + kb + (ks + 1) * 32); kn1 = *(const LAS bf16x8*)(lds + kb + 32 * KROW + (ks + 1) * 32); }
                    s0 = __builtin_amdgcn_mfma_f32_32x32x16_bf16(kf0, qr[ks], ks == 0 ? negm : s0, 0, 0, 0);
#pragma unroll
                    for (int i = (16 * ks) / 3; i < (16 * ks + 8) / 3; ++i) sacc += ATT_E(i);
#pragma unroll
                    for (int c = (8 * ks) / 3; c < (8 * ks + 4) / 3; ++c) pf[c >> 2][c & 3] = cvt_pk_bf16(ATT_E(2 * c), ATT_E(2 * c + 1));
                    ATT_SB();
                    s1 = __builtin_amdgcn_mfma_f32_32x32x16_bf16(kf1, qr[ks], ks == 0 ? negm : s1, 0, 0, 0);
#pragma unroll
                    for (int i = (16 * ks + 8) / 3; i < (16 * ks + 16) / 3; ++i) sacc += ATT_E(i);
#pragma unroll
                    for (int c = (8 * ks + 4) / 3; c < (8 * ks + 8) / 3; ++c) pf[c >> 2][c & 3] = cvt_pk_bf16(ATT_E(2 * c), ATT_E(2 * c + 1));
                    ATT_SB();
                    kf0 = kn0; kf1 = kn1;
                }
            }
            l_run += sacc;
            float fsc = 1.0f; bool resc = false;
            if (nx) {
                const int kv0 = (jt + 1) * 64;
                if (kv0 + 63 > q0) cmask(s0, s1, kv0, qidx, hi);
                float rm = rowmax32(s0, s1);
                if (__any(rm > THR)) {
                    rm = fmaxf(rm, __shfl_xor(rm, 32));
                    const float dl = fmaxf(rm, 0.f);
                    m_run += dl; fsc = __builtin_amdgcn_exp2f(-dl); l_run *= fsc; resc = true;
#pragma unroll
                    for (int r = 0; r < 16; ++r) { s0[r] -= dl; s1[r] -= dl; negm[r] = -m_run; }
                }
            }
            ATT_SB();
            {
#define ATT_VA(m) (vb + ((m) & 1) * 32 * VROW + ((m) >> 1) * 32)
                bf16x8 vq[3];
                vq[0] = *(const LAS bf16x8*)(lds + ATT_VA(0)); vq[1] = *(const LAS bf16x8*)(lds + ATT_VA(1));
#pragma unroll
                for (int m = 0; m < 8; ++m) {
                    if (m < 6) vq[(m + 2) % 3] = *(const LAS bf16x8*)(lds + ATT_VA(m + 2));
                    const bf16x8 vf = vq[m % 3];
                    const bf16x8 pb = __builtin_bit_cast(bf16x8, pf[m >> 1]);
                    if ((m & 1) == 0) o0 = __builtin_amdgcn_mfma_f32_32x32x16_bf16(vf, pb, o0, 0, 0, 0);
                    else o1 = __builtin_amdgcn_mfma_f32_32x32x16_bf16(vf, pb, o1, 0, 0, 0);
                    if (m < 4) {
#pragma unroll
                        for (int i = 4 * m; i < 4 * m + 4; ++i) e0[i] = __builtin_amdgcn_exp2f(s0[i]);
                        asm volatile("" : "+v"(e0));
                    } else {
#pragma unroll
                        for (int i = 4 * m - 16; i < 4 * m - 12; ++i) e1[i] = __builtin_amdgcn_exp2f(s1[i]);
                        asm volatile("" : "+v"(e1));
                    }
                    ATT_SB();
                }
#undef ATT_VA
            }
            if (resc) {
#pragma unroll
                for (int r = 0; r < 16; ++r) { o0[r] *= fsc; o1[r] *= fsc; }
            }
        }
        { const unsigned nb = (jt & 1) * KBUF; *(LAS u32x4*)(lds + nb + kn_dst) = gK[P]; *(LAS u32x4*)(lds + nb + kr_dst) = gR[P]; }
        { const unsigned nb = ((jt + 1) & 1) * VBUF; *(LAS u32x2*)(lds + nb + vt_dst) = (u32x2){gV[P].x, gV[P].y}; *(LAS u32x2*)(lds + nb + vt_dst + 16) = (u32x2){gV[P].z, gV[P].w}; }
        __syncthreads();
}
__device__ __forceinline__ void unit(LAS unsigned char* lds, int b, int h, int qb, const bf16_t* Q, const bf16_t* KN, const bf16_t* KR, const bf16_t* VT, bf16_t* O) {
    const int tid = opq_tid(), lane = tid & 63, wid = __builtin_amdgcn_readfirstlane(tid >> 6), r32 = lane & 31, hi = lane >> 5;
    const size_t tok0 = (size_t)b * SEQ;
    const int q0 = qb * 256 + wid * 32, qidx = q0 + r32, NT = 4 * (qb + 1), jmax = (q0 + 31) >> 6;
    bf16x8 qr[6];
    { const bf16_t* qp = Q + (tok0 + qidx) * QLD + h * 96 + hi * 8;
#pragma unroll
      for (int ks = 0; ks < 6; ++ks) qr[ks] = *(const GAS bf16x8*)(qp + ks * 16); }
    const int krow = tid >> 3, kch = tid & 7, rrow = (tid >> 2) & 63, rch = tid & 3;
    const bf16_t* kn_src = KN + (tok0 + krow) * 512 + h * 64 + kch * 8;
    const bf16_t* kr_src = KR + (tok0 + rrow) * 32 + rch * 8;
    const bf16_t* vt_src = VT + (size_t)(h * 64 + krow) * T + tok0 + kch * 8;
    const unsigned kn_dst = krow * KROW + kch * 16, kr_dst = rrow * KROW + 128 + rch * 16, vt_dst = V_OFF + krow * VROW + (kch >> 1) * 32 + (kch & 1) * 8;
    const bool has_r = tid < 256;
    u32x4 gk, gr = {0u, 0u, 0u, 0u}, gv;
    u32x4 gK[2], gR[2], gV[2];
    gK[0] = gr; gK[1] = gr; gR[0] = gr; gR[1] = gr; gV[0] = gr; gV[1] = gr;
    {
        gk = *(const GAS u32x4*)kn_src; if (has_r) gr = *(const GAS u32x4*)kr_src; gv = *(const GAS u32x4*)vt_src;
        const u32x4 gk1 = *(const GAS u32x4*)(kn_src + 64 * 512); u32x4 gr1 = {0u, 0u, 0u, 0u}; if (has_r) gr1 = *(const GAS u32x4*)(kr_src + 64 * 32);
        *(LAS u32x4*)(lds + kn_dst) = gk; if (has_r) *(LAS u32x4*)(lds + kr_dst) = gr;
        *(LAS u32x2*)(lds + vt_dst) = (u32x2){gv.x, gv.y}; *(LAS u32x2*)(lds + vt_dst + 16) = (u32x2){gv.z, gv.w};
        *(LAS u32x4*)(lds + KBUF + kn_dst) = gk1; if (has_r) *(LAS u32x4*)(lds + KBUF + kr_dst) = gr1;
        gK[0] = *(const GAS u32x4*)(kn_src + (size_t)2 * 64 * 512); gR[0] = *(const GAS u32x4*)(kr_src + (size_t)2 * 64 * 32); gV[0] = *(const GAS u32x4*)(vt_src + 64);
    }
    __syncthreads();
    const unsigned ka = r32 * KROW + hi * 16;
    const unsigned va = V_OFF + r32 * VROW + hi * 16;
    f32x16 o0, o1, negm, s0, s1, e0, e1;
#pragma unroll
    for (int r = 0; r < 16; ++r) { o0[r] = 0.f; o1[r] = 0.f; s0[r] = 0.f; s1[r] = 0.f; }
    float m_run, l_run = 0.f;
    {
#pragma unroll
        for (int ks = 0; ks < 6; ++ks) {
            const bf16x8 k0 = *(const LAS bf16x8*)(lds + ka + ks * 32), k1 = *(const LAS bf16x8*)(lds + ka + 32 * KROW + ks * 32);
            s0 = __builtin_amdgcn_mfma_f32_32x32x16_bf16(k0, qr[ks], s0, 0, 0, 0);
            s1 = __builtin_amdgcn_mfma_f32_32x32x16_bf16(k1, qr[ks], s1, 0, 0, 0);
        }
        if (63 > q0) cmask(s0, s1, 0, qidx, hi);
        float rm = rowmax32(s0, s1); rm = fmaxf(rm, __shfl_xor(rm, 32));
        m_run = rm;
#pragma unroll
        for (int r = 0; r < 16; ++r) { e0[r] = __builtin_amdgcn_exp2f(s0[r] - rm); e1[r] = __builtin_amdgcn_exp2f(s1[r] - rm); negm[r] = -rm; }
    }
    for (int jt = 0; jt < NT; jt += 2) {
        tile_iter<0>(lds, jt, NT, jmax, q0, qidx, hi, ka, va, kn_src, kr_src, vt_src, kn_dst, kr_dst, vt_dst, has_r, qr, o0, o1, negm, s0, s1, e0, e1, m_run, l_run, gK, gR, gV);
        tile_iter<1>(lds, jt + 1, NT, jmax, q0, qidx, hi, ka, va, kn_src, kr_src, vt_src, kn_dst, kr_dst, vt_dst, has_r, qr, o0, o1, negm, s0, s1, e0, e1, m_run, l_run, gK, gR, gV);
    }
    const float lt = l_run + __shfl_xor(l_run, 32);
    const float inv = 1.0f / lt;
    bf16_t* op = O + (tok0 + qidx) * 512 + h * 64 + 4 * hi;
#pragma unroll
    for (int g = 0; g < 4; ++g) {
        *(GAS u32x2*)(op + 8 * g) = (u32x2){cvt_pk_bf16(o0[4 * g] * inv, o0[4 * g + 1] * inv), cvt_pk_bf16(o0[4 * g + 2] * inv, o0[4 * g + 3] * inv)};
        *(GAS u32x2*)(op + 32 + 8 * g) = (u32x2){cvt_pk_bf16(o1[4 * g] * inv, o1[4 * g + 1] * inv), cvt_pk_bf16(o1[4 * g + 2] * inv, o1[4 * g + 3] * inv)};
    }
}
__device__ __forceinline__ void phase(LAS unsigned char* lds, const bf16_t* Q, const bf16_t* KN, const bf16_t* KR, const bf16_t* VT, bf16_t* O) {
    for (int j = blockIdx.x; j < 2048; j += gridDim.x) {
        const int bh = j & 63, qslot = j >> 6, k = qslot >> 2, s = qslot & 3, i = k >> 1;
        const int qb = (k & 1) ? 31 - (4 * i + s) : 4 * i + s;
        unit(lds, bh >> 3, bh & 7, qb, Q, KN, KR, VT, O);
    }
}
#undef ATT_SB
#undef ATT_E
}

__device__ __forceinline__ int src_col(int map, int n0) {
    const int pn = n0 >> 8, bj = (n0 >> 7) & 1, wc = (n0 >> 5) & 3;
    switch (map) {
        case 1: return bj * FF + 128 * pn + (n0 & 127);
        case 2: return pn < 2 ? 96 * (4 * pn + wc) + 32 * bj : 96 * (4 * bj + wc) + 64;
        case 3: return 128 * (4 * pn + wc) + 32 * bj;
        case 4: return 128 * (n0 >> 6) + 64 + (n0 & 63);
        case 5: return n0 < 4000 ? n0 : -1;
        default: return n0;
    }
}
__device__ __forceinline__ void tr_item(const float* W, int K, int pitch, bf16_t* WT, const float* scale, int map, int nblk, LAS float* scr, int item, int lane) {
    const int kb = item / nblk, nb = item % nblk, k0 = 64 * kb, n0 = 32 * nb;
    const int sc0 = src_col(map, n0);
#pragma unroll 8
    for (int i = 0; i < 32; ++i) { const int kk = 2 * i + (lane >> 5); float v = 0.f;
        if (sc0 >= 0) { v = ((const GAS float*)W)[(size_t)(k0 + kk) * pitch + sc0 + (lane & 31)]; if (scale) v *= ((const GAS float*)scale)[k0 + kk]; }
        scr[kk * 33 + (lane & 31)] = v; }
    asm volatile("s_waitcnt lgkmcnt(0)" ::: "memory");
    const int c = lane & 7;
#pragma unroll
    for (int j = 0; j < 4; ++j) { const int n = (lane >> 3) + 8 * j; const LAS float* s = scr + (8 * c) * 33 + n;
        u32x4 o; o.x = cvt_pk_bf16(s[0 * 33], s[1 * 33]); o.y = cvt_pk_bf16(s[2 * 33], s[3 * 33]); o.z = cvt_pk_bf16(s[4 * 33], s[5 * 33]); o.w = cvt_pk_bf16(s[6 * 33], s[7 * 33]);
        *(GAS u32x4*)(WT + (size_t)(n0 + n) * K + k0 + 8 * c) = o; }
    asm volatile("s_waitcnt lgkmcnt(0)" ::: "memory");
}

struct Args { const void* in[20]; float* out; unsigned char* ws; int ph_lo, ph_hi; };

__device__ __forceinline__ void gemv64(const LAS float* sc, LAS float* red, const float* W, int pitch, int n0, int nvalid, const float* bias, float* out, int ldo, int tid) {
    const int lane = tid & 63, wid = tid >> 6, n = n0 + lane; const bool valid = n < nvalid;
    const GAS float* Wg = (const GAS float*)W + (valid ? n : 0);
    float acc[8];
#pragma unroll
    for (int b = 0; b < 8; ++b) acc[b] = 0.f;
#pragma unroll 16
    for (int kk = 0; kk < 128; ++kk) { const int k = wid * 128 + kk; const float w = Wg[(size_t)k * pitch];
#pragma unroll
        for (int b = 0; b < 8; ++b) acc[b] += sc[b * 1024 + k] * w; }
#pragma unroll
    for (int b = 0; b < 8; ++b) red[(wid * 8 + b) * 64 + lane] = acc[b];
    __syncthreads();
    { float sum = (bias && valid) ? ((const GAS float*)bias)[n] : 0.f;
#pragma unroll
      for (int w = 0; w < 8; ++w) sum += red[(w * 8 + wid) * 64 + lane];
      ((GAS float*)out)[(size_t)wid * ldo + n] = valid ? sum : 0.f; }
    __syncthreads();
}
__device__ __forceinline__ void xa_phase(const Args& A, LAS unsigned char* lds) {
    const int tid = opq_tid(), lane = tid & 63, wid = tid >> 6;
    unsigned char* ws = opq(A.ws);
    const float* mod = (const float*)(ws + WS_MOD);
    const float* normw = (const float*)A.in[5];
    {
        LAS float* sc = (LAS float*)lds; LAS float* red = (LAS float*)(lds + 32768);
        for (int it = blockIdx.x; it < 240; it += gridDim.x) {
            int sub, g; const float* W; int pitch, nvalid, ldo; float* out;
            if (it < 88) { sub = 0; g = it; W = (const float*)A.in[6]; pitch = 2 * FF; nvalid = 2 * FF; ldo = 2 * FF; out = (float*)(ws + WS_SHW0); }
            else if (it < 152) { sub = 1; g = it - 88; W = (const float*)A.in[8]; pitch = 4000; nvalid = 4000; ldo = PROJ_LD; out = (float*)(ws + WS_SHW1); }
            else { sub = 2; g = it - 152; W = (const float*)A.in[6] + (size_t)DM * 2 * FF; pitch = 2 * FF; nvalid = 2 * FF; ldo = 2 * FF; out = (float*)(ws + WS_SHW2); }
            for (int i = tid; i < 8192; i += 512) sc[i] = ((const GAS float*)mod)[(size_t)(i >> 10) * MODLD + sub * 3072 + (i & 1023)];
            __syncthreads();
            gemv64(sc, red, W, pitch, g * 64, nvalid, nullptr, out, ldo, tid);
        }
        if ((int)blockIdx.x == (int)gridDim.x - 1) {
            float* av = (float*)(ws + WS_AVEC);
            for (int i = tid; i < 2 * 8 * 1024; i += 512) { const int sb = i >> 13, b = (i >> 10) & 7, c = i & 1023;
                ((GAS float*)av)[i] = ((const GAS float*)normw)[(sb + 1) * 1024 + c] * (1.0f + ((const GAS float*)mod)[(size_t)b * MODLD + (sb + 1) * 3072 + 1024 + c]); }
        }
    }
    const float* X = (const float*)A.in[0]; bf16_t* XA = (bf16_t*)(ws + WS_H); float* ssp = (float*)(ws + WS_SSP);
    const int gw = blockIdx.x * 8 + wid, NGW = gridDim.x * 8;
    for (int ch = gw; ch < T / 32; ch += NGW) {
        const int row0 = ch * 32, b = row0 / SEQ;
        const float* scp = mod + (size_t)b * MODLD + 1024;
        f32x4 a[4];
#pragma unroll
        for (int j = 0; j < 4; ++j) { const int c = 4 * lane + 256 * j; a[j] = *(const GAS f32x4*)(normw + c) * (*(const GAS f32x4*)(scp + c) + 1.0f); }
        f32x4 vn[4];
        { const float* xr = X + (size_t)row0 * DM + 4 * lane;
#pragma unroll
          for (int j = 0; j < 4; ++j) vn[j] = *(const GAS f32x4*)(xr + 256 * j); }
        for (int r = 0; r < 32; ++r) {
            f32x4 v[4]; float ss = 0.f;
#pragma unroll
            for (int j = 0; j < 4; ++j) v[j] = vn[j];
            if (r < 31) { const float* xr = X + (size_t)(row0 + r + 1) * DM + 4 * lane;
#pragma unroll
                for (int j = 0; j < 4; ++j) vn[j] = *(const GAS f32x4*)(xr + 256 * j); }
#pragma unroll
            for (int j = 0; j < 4; ++j) { const f32x4 q = v[j] * v[j]; ss += (q[0] + q[1]) + (q[2] + q[3]); }
            ss = wave_sum(ss);
            bf16_t* hr = XA + (size_t)(row0 + r) * DM + 4 * lane;
#pragma unroll
            for (int j = 0; j < 4; ++j) { const f32x4 o = v[j] * a[j]; *(GAS u32x2*)(hr + 256 * j) = (u32x2){cvt_pk_bf16(o[0], o[1]), cvt_pk_bf16(o[2], o[3])}; }
            if (lane < 16) ((GAS float*)ssp)[(size_t)(row0 + r) * 16 + lane] = lane == 0 ? ss : 0.f;
        }
    }
}

__device__ __forceinline__ void unpack8(const u32x4 w, float (&f)[8]) { f[0] = bf_lo(w.x); f[1] = bf_hi(w.x); f[2] = bf_lo(w.y); f[3] = bf_hi(w.y); f[4] = bf_lo(w.z); f[5] = bf_hi(w.z); f[6] = bf_lo(w.w); f[7] = bf_hi(w.w); }

__device__ __forceinline__ void conv_phase(const bf16_t* P, const float* convw, const float* krw, const float* cosT, const float* sinT, float* rstdq, float* rstdkv, bf16_t* KR, bf16_t* OC) {
    const int tid = opq_tid(), lane = tid & 63, gw = blockIdx.x * 8 + (tid >> 6), NGW = gridDim.x * 8;
    float w0[8], w1[8], w2[8];
#pragma unroll
    for (int e = 0; e < 8; ++e) { w0[e] = convw[8 * lane + e]; w1[e] = convw[512 + 8 * lane + e]; w2[e] = convw[1024 + 8 * lane + e]; }
    const int kl = (lane - 48) & 3;
    float kw[8];
#pragma unroll
    for (int e = 0; e < 8; ++e) kw[e] = krw[8 * kl + e];
    for (int ch = gw; ch < T / 32; ch += NGW) {
        const int row0 = ch * 32, s0 = row0 % SEQ;
        float um2[8], um1[8];
#pragma unroll
        for (int e = 0; e < 8; ++e) { um2[e] = 0.f; um1[e] = 0.f; }
        if (s0 > 0) {
            float a[8], c[8];
            unpack8(*(const GAS u32x4*)(P + (size_t)(row0 - 2) * PROJ_LD + C_CONV + 8 * lane), a); unpack8(*(const GAS u32x4*)(P + (size_t)(row0 - 2) * PROJ_LD + C_GC + 8 * lane), c);
#pragma unroll
            for (int e = 0; e < 8; ++e) um2[e] = a[e] * c[e];
            unpack8(*(const GAS u32x4*)(P + (size_t)(row0 - 1) * PROJ_LD + C_CONV + 8 * lane), a); unpack8(*(const GAS u32x4*)(P + (size_t)(row0 - 1) * PROJ_LD + C_GC + 8 * lane), c);
#pragma unroll
            for (int e = 0; e < 8; ++e) um1[e] = a[e] * c[e];
        }
        u32x4 nxv, ngb, ngc, nst = {0u, 0u, 0u, 0u};
        { const bf16_t* pr = P + (size_t)row0 * PROJ_LD;
          nxv = *(const GAS u32x4*)(pr + C_CONV + 8 * lane); ngb = *(const GAS u32x4*)(pr + C_GB + 8 * lane); ngc = *(const GAS u32x4*)(pr + C_GC + 8 * lane);
          if (lane < 52) nst = *(const GAS u32x4*)(pr + 8 * lane); }
        for (int r = 0; r < 32; ++r) {
            const size_t row = (size_t)(row0 + r);
            float xv[8], gb[8], gc[8], st[8];
            unpack8(nxv, xv); unpack8(ngb, gb); unpack8(ngc, gc); unpack8(nst, st);
            if (r < 31) { const bf16_t* pr = P + (row + 1) * PROJ_LD;
                nxv = *(const GAS u32x4*)(pr + C_CONV + 8 * lane); ngb = *(const GAS u32x4*)(pr + C_GB + 8 * lane); ngc = *(const GAS u32x4*)(pr + C_GC + 8 * lane);
                if (lane < 52) nst = *(const GAS u32x4*)(pr + 8 * lane); }
            float o[8];
#pragma unroll
            for (int e = 0; e < 8; ++e) { const float u = gc[e] * xv[e]; o[e] = gb[e] * (w0[e] * um2[e] + w1[e] * um1[e] + w2[e] * u); um2[e] = um1[e]; um1[e] = u; }
            *(GAS u32x4*)(OC + row * 512 + 8 * lane) = (u32x4){cvt_pk_bf16(o[0], o[1]), cvt_pk_bf16(o[2], o[3]), cvt_pk_bf16(o[4], o[5]), cvt_pk_bf16(o[6], o[7])};
            float ss = 0.f;
#pragma unroll
            for (int e = 0; e < 8; ++e) ss += st[e] * st[e];
            const float sq = wave_sum(lane < 32 ? ss : 0.f), skv = wave_sum((lane >= 32 && lane < 48) ? ss : 0.f), skr = wave_sum((lane >= 48 && lane < 52) ? ss : 0.f);
            { const float rn = lane < 32 ? rsqrtf(sq * (1.0f / 256.0f) + EPS) : rsqrtf(skv * (1.0f / 128.0f) + EPS);
              if (lane < 48) *(GAS u32x4*)((bf16_t*)P + row * PROJ_LD + 8 * lane) = (u32x4){cvt_pk_bf16(st[0] * rn, st[1] * rn), cvt_pk_bf16(st[2] * rn, st[3] * rn), cvt_pk_bf16(st[4] * rn, st[5] * rn), cvt_pk_bf16(st[6] * rn, st[7] * rn)}; }
            const float rk = rsqrtf(skr * (1.0f / 32.0f) + EPS);
            const f32x4 c0 = *(const GAS f32x4*)(cosT + row * 16 + 8 * (kl & 1)), c1 = *(const GAS f32x4*)(cosT + row * 16 + 8 * (kl & 1) + 4);
            const f32x4 s0v = *(const GAS f32x4*)(sinT + row * 16 + 8 * (kl & 1)), s1v = *(const GAS f32x4*)(sinT + row * 16 + 8 * (kl & 1) + 4);
            const float sgn = (kl < 2) ? -1.0f : 1.0f;
            float ko[8];
#pragma unroll
            for (int e = 0; e < 8; ++e) { const float y = st[e] * rk * kw[e]; const float pt = __shfl_xor(y, 2);
                const float cc = e < 4 ? c0[e & 3] : c1[e & 3], sn = e < 4 ? s0v[e & 3] : s1v[e & 3]; ko[e] = y * cc + sgn * pt * sn; }
            if (lane >= 48 && lane < 52) *(GAS u32x4*)(KR + row * 32 + 8 * kl) = (u32x4){cvt_pk_bf16(ko[0], ko[1]), cvt_pk_bf16(ko[2], ko[3]), cvt_pk_bf16(ko[4], ko[5]), cvt_pk_bf16(ko[6], ko[7])};
        }
    }
}

__device__ const float INV_FREQ[16] = {1.0f, 0.5623413324356079f, 0.3162277638912201f, 0.17782793939113617f, 0.10000000149011612f, 0.05623412877321243f, 0.03162277862429619f, 0.017782794311642647f,
    0.009999999776482582f, 0.005623413249850273f, 0.003162277862429619f, 0.0017782794311642647f, 0.0010000000474974513f, 0.000562341301701963f, 0.0003162277862429619f, 0.00017782794020604342f};

__device__ __forceinline__ void sincos_reduced(float ang, float& s, float& c) {
    const double x = (double)ang;
    const double k = __builtin_rint(x * 0.15915494309189535);
    const float r = (float)(x - k * 6.283185307179586);
    s = __sinf(r); c = __cosf(r);
}

__device__ __forceinline__ void prologue(const Args& A, LAS unsigned char* lds) {
    const int tid = opq_tid(), lane = tid & 63, wid = tid >> 6;
    unsigned char* ws = opq(A.ws);
    {
        LAS float* sc = (LAS float*)lds; LAS float* red = (LAS float*)(lds + 32768);
        const float* c = (const float*)A.in[1];
        if ((int)blockIdx.x < 144) {
            for (int i = tid; i < 8192; i += 512) { const float v = ((const GAS float*)c)[i]; sc[i] = v / (1.0f + __expf(-v)); }
            __syncthreads();
        }
        for (int cgp = blockIdx.x; cgp < 144; cgp += gridDim.x)
            gemv64(sc, red, (const float*)A.in[3], MODLD, cgp * 64, MODLD, (const float*)A.in[4], (float*)(ws + WS_MOD), MODLD, tid);
    }
    __syncthreads();
    {
        const int* pos = (const int*)A.in[2]; float* cosT = (float*)(ws + WS_COS); float* sinT = (float*)(ws + WS_SIN);
        for (int idx = blockIdx.x * 512 + tid; idx < T * 16; idx += gridDim.x * 512) {
            const float ang = (float)((const GAS int*)pos)[idx >> 4] * INV_FREQ[idx & 15]; float s, c; sincos_reduced(ang, s, c); ((GAS float*)cosT)[idx] = c; ((GAS float*)sinT)[idx] = s; }
    }
    {
        LAS float* scr = (LAS float*)(lds + wid * 16384);
        const int gw = blockIdx.x * 8 + wid, NGW = gridDim.x * 8;
        const float* w13 = (const float*)A.in[6]; const float* w2 = (const float*)A.in[7]; const float* win = (const float*)A.in[8];
        const float* qan = (const float*)A.in[9]; const float* wuq = (const float*)A.in[10]; const float* kvan = (const float*)A.in[11]; const float* wukv = (const float*)A.in[12];
        const float* wbr = (const float*)A.in[18]; const float* wout = (const float*)A.in[19];
        constexpr int I13 = 16 * 176, I2 = 44 * 32, IIN = 16 * 128, IUQ = 4 * 24, IUK = 2 * 16, IV = 2 * 16, IB = 8 * 32, IO = 16 * 32;
        constexpr int NIT = 2 * I13 + 2 * I2 + IIN + IUQ + IUK + IV + 2 * IB + IO;
        for (int it = gw; it < NIT; it += NGW) {
            int r = it;
            if (r < I13) { tr_item(w13, 1024, 5632, (bf16_t*)(ws + WS_W13A), nullptr, 1, 176, scr, r, lane); continue; } r -= I13;
            if (r < I13) { tr_item(w13 + (size_t)1024 * 5632, 1024, 5632, (bf16_t*)(ws + WS_W13B), nullptr, 1, 176, scr, r, lane); continue; } r -= I13;
            if (r < I2) { tr_item(w2, 2816, 1024, (bf16_t*)(ws + WS_W2A), nullptr, 0, 32, scr, r, lane); continue; } r -= I2;
            if (r < I2) { tr_item(w2 + (size_t)2816 * 1024, 2816, 1024, (bf16_t*)(ws + WS_W2B), nullptr, 0, 32, scr, r, lane); continue; } r -= I2;
            if (r < IIN) { tr_item(win, 1024, 4000, (bf16_t*)(ws + WS_WIN), nullptr, 5, 128, scr, r, lane); continue; } r -= IIN;
            if (r < IUQ) { tr_item(wuq, 256, 768, (bf16_t*)(ws + WS_WUQ), qan, 2, 24, scr, r, lane); continue; } r -= IUQ;
            if (r < IUK) { tr_item(wukv, 128, 1024, (bf16_t*)(ws + WS_WUK), kvan, 3, 16, scr, r, lane); continue; } r -= IUK;
            if (r < IV) { tr_item(wukv, 128, 1024, (bf16_t*)(ws + WS_WV), kvan, 4, 16, scr, r, lane); continue; } r -= IV;
            if (r < IB) { tr_item(wbr, 512, 1024, (bf16_t*)(ws + WS_WB0), nullptr, 0, 32, scr, r, lane); continue; } r -= IB;
            if (r < IB) { tr_item(wbr + (size_t)512 * 1024, 512, 1024, (bf16_t*)(ws + WS_WB1), nullptr, 0, 32, scr, r, lane); continue; } r -= IB;
            tr_item(wout, 1024, 1024, (bf16_t*)(ws + WS_WOUT), nullptr, 0, 32, scr, r, lane);
        }
    }
    __syncthreads();
}

#define XB_TMO      128
#define XB_XCNT(j)  (256  + 64 * (j))
#define XB_XSUB(j)  (1280 + 64 * (j))
#define XB_XGEN(j)  (2304 + 64 * (j))
#define XB_TOP      3328
#define XB_TOPGEN   3392
#define XCD_BAR_WORDS 3456
#define XB_SPIN_CAP (1u << 22)
__device__ __forceinline__ unsigned xb_ld(unsigned* p)              { return __hip_atomic_load(p, __ATOMIC_RELAXED, __HIP_MEMORY_SCOPE_AGENT); }
__device__ __forceinline__ unsigned xb_add(unsigned* p, unsigned v) { return __hip_atomic_fetch_add(p, v, __ATOMIC_RELAXED, __HIP_MEMORY_SCOPE_AGENT); }
__device__ __forceinline__ unsigned xb_xcc_id() { return (unsigned)__builtin_amdgcn_s_getreg((3 << 11) | 20) & 0xFu; }
#define XB_SPIN(cond, bar) do { unsigned _sp = 0; while (cond) { __builtin_amdgcn_s_sleep(1); \
    if ((++_sp & 255u) == 0u) { if (xb_ld(&(bar)[XB_TMO])) break; if (_sp > XB_SPIN_CAP) { atomicAdd(&(bar)[XB_TMO], 1u); break; } } } } while (0)
struct XcdBarrier { unsigned* bar; unsigned x; volatile LAS unsigned* st; };
__device__ __forceinline__ XcdBarrier xcd_barrier_post(unsigned* bar, volatile LAS unsigned* st, int tid) {
    XcdBarrier b; b.bar = bar; b.x = xb_xcc_id(); b.st = st;
    if (tid == 0) (void)xb_add(&bar[XB_XCNT(b.x)], 1u);
    return b;
}
__device__ __forceinline__ void xcd_barrier_complete(unsigned* bar, unsigned x, unsigned& nloc, unsigned& nx) {
    const unsigned G = gridDim.x;
    unsigned sum, cnt, mine, sp = 0u;
    for (;;) {
        sum = 0u; cnt = 0u; mine = 0u;
#pragma unroll
        for (unsigned j = 0; j < 16; ++j) { const unsigned c = xb_ld(&bar[XB_XCNT(j)]); sum += c; cnt += (c > 0u) ? 1u : 0u; mine = (j == x) ? c : mine; }
        if (sum == G) break;
        __builtin_amdgcn_s_sleep(1);
        if ((++sp & 255u) == 0u) { if (xb_ld(&bar[XB_TMO])) break; if (sp > XB_SPIN_CAP) { atomicAdd(&bar[XB_TMO], 1u); break; } }
    }
    nloc = mine > 0u ? mine : 1u; nx = cnt > 0u ? cnt : 1u;
}
__device__ __forceinline__ void xcd_barrier(const XcdBarrier& b) {
    asm volatile("s_waitcnt vmcnt(0)" ::: "memory");
    __syncthreads();
    if (opq_tid() == 0) {
        unsigned* bar = b.bar;
        __builtin_amdgcn_s_waitcnt(0);
        unsigned nloc = b.st[0], nx = b.st[1];
        if (nloc == 0u) { xcd_barrier_complete(bar, b.x, nloc, nx); b.st[0] = nloc; b.st[1] = nx; }
        const unsigned old = xb_add(&bar[XB_XSUB(b.x)], 1u);
        const unsigned gen = old / nloc;
        if (old + 1u == (gen + 1u) * nloc) {
            __builtin_amdgcn_fence(__ATOMIC_RELEASE, "agent");
            asm volatile("s_waitcnt vmcnt(0)" ::: "memory");
            const unsigned og = xb_add(&bar[XB_TOP], 1u);
            const unsigned tg = og / nx;
            if (og + 1u == (tg + 1u) * nx) xb_add(&bar[XB_TOPGEN], 1u);
            else XB_SPIN(xb_ld(&bar[XB_TOPGEN]) == tg, bar);
            __builtin_amdgcn_fence(__ATOMIC_ACQUIRE, "agent");
            xb_add(&bar[XB_XGEN(b.x)], 1u);
            asm volatile("s_waitcnt vmcnt(0)" ::: "memory");
        } else {
            XB_SPIN(xb_ld(&bar[XB_XGEN(b.x)]) == gen, bar);
            __builtin_amdgcn_fence(__ATOMIC_ACQUIRE, "agent");
            asm volatile("s_waitcnt vmcnt(0)" ::: "memory");
        }
    }
    __syncthreads();
}

#ifndef MK_PER_PHASE
#define MK_PER_PHASE 0
#endif
__global__ void __launch_bounds__(512) fwd_kernel(Args A) {
    extern __shared__ __attribute__((aligned(16))) unsigned char lds_raw[];
    LAS unsigned char* lds = (LAS unsigned char*)lds_raw;
    cg::grid_group grid = cg::this_grid();
    const int G = gridDim.x, cidx = blockIdx.x;
    { const int t0 = opq_tid(); if (t0 < 32) ((LAS unsigned*)(lds + LDS_MISC))[t0] = 0u; __syncthreads(); }
    (void)xcd_barrier_post((unsigned*)(A.ws + WS_BAR), (volatile LAS unsigned*)(lds + LDS_MISC), opq_tid());
    const int lo = A.ph_lo, hi = A.ph_hi; (void)lo; (void)hi;
#if MK_PER_PHASE
#define IN(k) (lo <= (k) && (k) < hi)
#define SEAM(k) do { } while (0)
#else
#define IN(k) true
#define SEAM(k) do { if ((k) == 0) grid.sync(); else { XcdBarrier xb_; xb_.bar = (unsigned*)(opq(A.ws) + WS_BAR); xb_.x = xb_xcc_id(); xb_.st = (volatile LAS unsigned*)(lds + LDS_MISC); xcd_barrier(xb_); } } while (0)
#endif
#define WSP(T_, off) ((T_*)(ws + (off)))
#ifndef DUP
#define DUP 0
#endif
#if DUP
#define REP(k) for (int rep_ = 0; rep_ <= ((DUP >> (k)) & 1); ++rep_)
#else
#define REP(k)
#endif
    using namespace pg8;

    REP(0) { if (IN(0)) { prologue(A, lds); } SEAM(0); }
    REP(1) { if (IN(1)) { xa_phase(A, lds); } SEAM(1); }
    REP(2) { if (IN(2)) { unsigned char* ws = opq(A.ws); Gemm g{WSP(const bf16_t, WS_H), WSP(const bf16_t, WS_W13A), T, 2 * FF, DM, DM, DM}; StaticOrder S; S.init(T, 2 * FF, G, cidx);
        EpiSwiGLU E{WSP(bf16_t, WS_BIG), WSP(const float, WS_SSP), WSP(const float, WS_SHW0)}; gemm_phase<EpiSwiGLU, StaticOrder, true>(lds, g, S, E); } SEAM(2); }
    REP(3) { if (IN(3)) { unsigned char* ws = opq(A.ws); Gemm g{WSP(const bf16_t, WS_BIG), WSP(const bf16_t, WS_W2A), T, DM, FF, FF, FF}; StaticOrder S; S.init(T, DM, G, cidx);
        EpiResidN<0> E{opq((const float*)A.in[0]), opq(A.out), WSP(bf16_t, WS_H), WSP(float, WS_SSP), WSP(const float, WS_MOD) + 0 * 3072 + 2048, WSP(const float, WS_AVEC), 0.5f};
        gemm_phase<EpiResidN<0>, StaticOrder, true>(lds, g, S, E); } SEAM(3); }
    REP(5) { if (IN(5)) { unsigned char* ws = opq(A.ws); Gemm g{WSP(const bf16_t, WS_H), WSP(const bf16_t, WS_WIN), T, PROJ_LD, DM, DM, DM}; StaticOrder S; S.init(T, PROJ_LD, G, cidx);
        EpiProj E{WSP(bf16_t, WS_BIG), WSP(const float, WS_SSP), WSP(const float, WS_SHW1)}; gemm_phase<EpiProj, StaticOrder, true>(lds, g, S, E); } SEAM(5); }
    REP(6) { if (IN(6)) { unsigned char* ws = opq(A.ws); conv_phase(WSP(const bf16_t, WS_BIG), (const float*)A.in[17], (const float*)A.in[16], WSP(const float, WS_COS), WSP(const float, WS_SIN),
        WSP(float, WS_RSTDQ), WSP(float, WS_RSTDKV), WSP(bf16_t, WS_KR), WSP(bf16_t, WS_OCONV)); } SEAM(6); }
    REP(7) { if (IN(7)) {
        { unsigned char* ws = opq(A.ws); Gemm g{WSP(const bf16_t, WS_BIG), WSP(const bf16_t, WS_WUQ), T, 768, 256, PROJ_LD, 256}; StaticOrder S; S.init(T, 768, G, cidx);
          EpiQK<2> E{WSP(bf16_t, WS_Q), QLD, 96, WSP(const float, WS_RSTDQ), (const float*)A.in[13], (const float*)A.in[15], WSP(const float, WS_COS), WSP(const float, WS_SIN), QSCALE};
          gemm_phase<EpiQK<2>, StaticOrder, true>(lds, g, S, E); }
        { unsigned char* ws = opq(A.ws); Gemm g{WSP(const bf16_t, WS_BIG) + 256, WSP(const bf16_t, WS_WUK), T, 512, 128, PROJ_LD, 128}; StaticOrder S; S.init(T, 512, G, cidx);
          EpiQK<-1> E{WSP(bf16_t, WS_KN), 512, 64, WSP(const float, WS_RSTDKV), (const float*)A.in[14], nullptr, nullptr, nullptr, 1.0f};
          gemm_phase<EpiQK<-1>, StaticOrder, true>(lds, g, S, E); }
        { unsigned char* ws = opq(A.ws); Gemm g{WSP(const bf16_t, WS_WV), WSP(const bf16_t, WS_BIG) + 256, 512, T, 128, 128, PROJ_LD}; StaticOrder S; S.init(512, T, G, cidx);
          EpiVT E{WSP(bf16_t, WS_VT), WSP(const float, WS_RSTDKV)}; gemm_phase<EpiVT, StaticOrder, true>(lds, g, S, E); }
    } SEAM(7); }
    REP(8) { if (IN(8)) { unsigned char* ws = opq(A.ws); att::phase(lds, WSP(const bf16_t, WS_Q), WSP(const bf16_t, WS_KN), WSP(const bf16_t, WS_KR), WSP(const bf16_t, WS_VT), WSP(bf16_t, WS_OATT)); } SEAM(8); }
    REP(9) { if (IN(9)) {
        { unsigned char* ws = opq(A.ws); Gemm g{WSP(const bf16_t, WS_OATT), WSP(const bf16_t, WS_WB0), T, DM, 512, 512, 512}; StaticOrder S; S.init(T, DM, G, cidx);
          EpiBranch<true> E{WSP(bf16_t, WS_MERGED), WSP(const bf16_t, WS_BIG) + C_GL}; gemm_phase<EpiBranch<true>, StaticOrder, true>(lds, g, S, E); }
        { unsigned char* ws = opq(A.ws); Gemm g{WSP(const bf16_t, WS_OCONV), WSP(const bf16_t, WS_WB1), T, DM, 512, 512, 512}; StaticOrder S; S.init(T, DM, G, cidx);
          EpiBranch<false> E{WSP(bf16_t, WS_MERGED), WSP(const bf16_t, WS_BIG) + C_GL + 1024}; gemm_phase<EpiBranch<false>, StaticOrder, true>(lds, g, S, E); }
    } SEAM(9); }
    REP(10) { if (IN(10)) { unsigned char* ws = opq(A.ws); Gemm g{WSP(const bf16_t, WS_MERGED), WSP(const bf16_t, WS_WOUT), T, DM, DM, DM, DM}; StaticOrder S; S.init(T, DM, G, cidx);
        EpiResidN<1> E{opq(A.out), WSP(bf16_t, WS_X2B), WSP(bf16_t, WS_H), WSP(float, WS_SSP), WSP(const float, WS_MOD) + 1 * 3072 + 2048, WSP(const float, WS_AVEC) + 8 * 1024, 1.0f};
        gemm_phase<EpiResidN<1>, StaticOrder, true>(lds, g, S, E); } SEAM(10); }
    REP(12) { if (IN(12)) { unsigned char* ws = opq(A.ws); Gemm g{WSP(const bf16_t, WS_H), WSP(const bf16_t, WS_W13B), T, 2 * FF, DM, DM, DM}; StaticOrder S; S.init(T, 2 * FF, G, cidx);
        EpiSwiGLU E{WSP(bf16_t, WS_BIG), WSP(const float, WS_SSP), WSP(const float, WS_SHW2)}; gemm_phase<EpiSwiGLU, StaticOrder, true>(lds, g, S, E); } SEAM(12); }
    if (IN(13)) { unsigned char* ws = opq(A.ws); Gemm g{WSP(const bf16_t, WS_BIG), WSP(const bf16_t, WS_W2B), T, DM, FF, FF, FF}; StaticOrder S; S.init(T, DM, G, cidx);
        EpiResidN<2> E{WSP(const bf16_t, WS_X2B), opq(A.out), nullptr, nullptr, WSP(const float, WS_MOD) + 2 * 3072 + 2048, nullptr, 0.5f};
        gemm_phase<EpiResidN<2>, StaticOrder, true>(lds, g, S, E); }
#undef IN
#undef SEAM
#undef WSP
#undef REP
}

extern "C" void kernel_launch(void* const* d_in, const int* in_sizes, int n_in, void* d_out, int out_size, void* d_ws, size_t ws_size, hipStream_t stream) {
    static int grid = 0;
    if (grid == 0) {
        if (n_in != 20 || out_size != T * DM || ws_size < WS_END) { fprintf(stderr, "kernel_launch: unexpected shapes (n_in %d out %d ws %zu)\n", n_in, out_size, ws_size); grid = -1; return; }
        int dev = 0, cus = 0, per_cu = 0;
        hipGetDevice(&dev); hipDeviceGetAttribute(&cus, hipDeviceAttributeMultiprocessorCount, dev);
        if (hipFuncSetAttribute((const void*)fwd_kernel, hipFuncAttributeMaxDynamicSharedMemorySize, LDS_BYTES) != hipSuccess) { fprintf(stderr, "kernel_launch: hipFuncSetAttribute failed\n"); grid = -1; return; }
        if (hipOccupancyMaxActiveBlocksPerMultiprocessor(&per_cu, (const void*)fwd_kernel, 512, LDS_BYTES) != hipSuccess || per_cu < 1) per_cu = 1;
        (void)hipGetLastError();
        grid = cus * per_cu;
        if (grid > 256) grid = 256;
    }
    if (grid < 0) return;
    if (hipMemsetAsync((char*)d_ws + WS_BAR, 0, BAR_BYTES, stream) != hipSuccess) { fprintf(stderr, "kernel_launch: memset failed\n"); return; }
    Args a{};
    for (int i = 0; i < 20; ++i) a.in[i] = d_in[i];
    a.out = (float*)d_out; a.ws = (unsigned char*)d_ws;
#if MK_PER_PHASE
    for (int p = 0; p < 14; ++p) { a.ph_lo = p; a.ph_hi = p + 1; hipLaunchKernelGGL(fwd_kernel, dim3(grid), dim3(512), LDS_BYTES, stream, a); }
#else
    a.ph_lo = 0; a.ph_hi = 14;
    void* args[] = {&a};
    hipError_t e = hipLaunchCooperativeKernel((const void*)fwd_kernel, dim3(grid), dim3(512), args, LDS_BYTES, stream);
    if (e != hipSuccess) fprintf(stderr, "cooperative launch failed: %s (grid %d)\n", hipGetErrorString(e), grid);
#endif
}
```

```cpp
#include <hip/hip_runtime.h>
#include <hip/hip_cooperative_groups.h>
#include <cstdio>
#include <cstdint>
namespace cg = cooperative_groups;

#define LAS __attribute__((address_space(3)))
#define GAS __attribute__((address_space(1)))
typedef unsigned short bf16_t;
typedef short bf16x8 __attribute__((ext_vector_type(8)));
typedef float f32x4 __attribute__((ext_vector_type(4)));
typedef float f32x16 __attribute__((ext_vector_type(16)));
typedef unsigned u32x4 __attribute__((ext_vector_type(4)));
typedef unsigned u32x2 __attribute__((ext_vector_type(2)));

constexpr int BATCH = 8, SEQ = 8192, T = BATCH * SEQ, DM = 1024, FF = 2816, NH = 8;
constexpr int QLD = 768, PROJ_LD = 4096, MODLD = 9216;
constexpr int C_CONV = 416, C_GB = 928, C_GC = 1440, C_GL = 1952;
constexpr float EPS = 1e-6f;
constexpr float QSCALE = 0.10206207261596577f * 1.4426950408889634f;

constexpr size_t MiB = 1u << 20;
constexpr size_t WS_MOD = 0, WS_RSTDQ = 1 * MiB, WS_RSTDKV = 1 * MiB + 512 * 1024, WS_COS = 2 * MiB, WS_SIN = 6 * MiB, WS_KR = 10 * MiB;
constexpr size_t WS_W13A = 16 * MiB, WS_W13B = 27 * MiB, WS_W2A = 38 * MiB, WS_W2B = 38 * MiB + 5632 * 1024, WS_WIN = 49 * MiB;
constexpr size_t WS_WUQ = 57 * MiB, WS_WUK = 57 * MiB + 512 * 1024, WS_WV = 57 * MiB + 768 * 1024, WS_WB0 = 58 * MiB, WS_WB1 = 59 * MiB, WS_WOUT = 60 * MiB;
constexpr size_t WS_H = 64 * MiB, WS_OATT = 64 * MiB, WS_OCONV = 128 * MiB;
constexpr size_t WS_BIG = 192 * MiB;
constexpr size_t WS_Q = 704 * MiB, WS_KN = 800 * MiB, WS_MERGED = 704 * MiB, WS_VT = 864 * MiB, WS_SSP = 928 * MiB, WS_END = 932 * MiB;
constexpr size_t WS_SHW0 = 14 * MiB, WS_SHW1 = 14 * MiB + 256 * 1024, WS_SHW2 = 14 * MiB + 512 * 1024, WS_AVEC = 14 * MiB + 768 * 1024;
constexpr size_t WS_X2B = 544 * MiB;

constexpr size_t WS_BAR = 15 * MiB, BAR_BYTES = 16384;
constexpr int LDS_BYTES = 147456, LDS_MISC = 131072 + 320;

template <class P> __device__ __forceinline__ P* opq(P* p) { asm volatile("" : "+s"(p)); return p; }
__device__ __forceinline__ int opq_tid() { int t = threadIdx.x; asm volatile("" : "+v"(t)); return t; }
__device__ __forceinline__ unsigned cvt_pk_bf16(float lo, float hi) { unsigned r; asm("v_cvt_pk_bf16_f32 %0, %1, %2" : "=v"(r) : "v"(lo), "v"(hi)); return r; }
__device__ __forceinline__ float bf_lo(unsigned w) { return __uint_as_float(w << 16); }
__device__ __forceinline__ float bf_hi(unsigned w) { return __uint_as_float(w & 0xffff0000u); }
__device__ __forceinline__ float fast_sigmoid(float x) { return __builtin_amdgcn_rcpf(1.0f + __expf(-x)); }
__device__ __forceinline__ u32x4 pack8(f32x4 a, f32x4 b) { u32x4 w; w.x = cvt_pk_bf16(a[0], a[1]); w.y = cvt_pk_bf16(a[2], a[3]); w.z = cvt_pk_bf16(b[0], b[1]); w.w = cvt_pk_bf16(b[2], b[3]); return w; }
__device__ __forceinline__ float wave_sum(float v) {
#pragma unroll
    for (int o = 1; o < 64; o <<= 1) v += __shfl_xor(v, o);
    return v;
}

namespace pg8 {
constexpr int BM = 256, BK = 64, HALF = 128, HTB = HALF * BK * 2, STAGE_BYTES = 8 * HTB, NXCD = 8, WGM = 8;
__host__ __device__ __forceinline__ int lds_byte(int r, int c) { const int st = (r >> 4) * 2 + (c >> 5), rr = r & 15, cc = c & 31, ob = rr * 64 + cc * 2; return st * 1024 + (ob ^ (((ob >> 9) & 1) << 5)); }
__host__ __device__ __forceinline__ void stage_rc(int b, int& R, int& C) { const int st = b / 1024, sb = b % 1024, swz = sb ^ (((sb >> 9) & 1) << 5); R = (st >> 1) * 16 + swz / 64; C = (st & 1) * 32 + (swz % 64) / 2; }
__host__ __device__ __forceinline__ int perm32(int rho) { const int n = rho >> 4, i = rho & 15; return 8 * (i >> 2) + 4 * n + (i & 3); }

struct Unit { int pm, pn; };
struct Gemm { const bf16_t* A; const bf16_t* Bt; int M, N, K, lda, ldb; };

struct StaticOrder {
    int nM, nN, nwg, G, c;
    __host__ __device__ void init(int M, int N, int G_, int c_) { nM = M / BM; nN = N / BM; nwg = nM * nN; G = G_; c = c_; }
    __host__ __device__ bool next(int i, Unit& u) const {
        const long L = (long)i * G + c; if (L >= nwg) return false;
        int wgid = (int)L; { const int q = nwg / NXCD, r = nwg % NXCD, xcd = wgid % NXCD, off = wgid / NXCD; wgid = (xcd < r ? xcd * (q + 1) : r * (q + 1) + (xcd - r) * q) + off; }
        const int nig = WGM * nN, gid = wgid / nig, fm = gid * WGM, gsz = (nM - fm) < WGM ? (nM - fm) : WGM;
        u.pm = fm + ((wgid % nig) % gsz); u.pn = (wgid % nig) / gsz; return true;
    }
};

template <class Epi, class Sched, bool ALIGN_EPI>
__device__ __forceinline__ void gemm_phase(LAS unsigned char* lds, const Gemm g, const Sched& S, const Epi& E) {
    int tid_ = threadIdx.x; asm volatile("" : "+v"(tid_));
    const int tid = tid_, wid = __builtin_amdgcn_readfirstlane(tid >> 6), lane = tid & 63, wr = wid >> 2, wc = wid & 3, fr = lane & 15, fq = lane >> 4;
    const int K = g.K, nt = K / BK;
    unsigned voffA[2], voffB[2];
#pragma unroll
    for (int i = 0; i < 2; ++i) { int R, C; stage_rc(tid * 16 + i * 8192, R, C); const int Rb = Epi::PERM ? ((R & ~31) + perm32(R & 31)) : R;
        voffA[i] = (unsigned)(R * g.lda + C) * 2u; voffB[i] = (unsigned)(Rb * g.ldb + C) * 2u; }
    const size_t kstep = (size_t)(BK * 2);
    const size_t hstepA = (size_t)HALF * g.lda * 2, hstepB = (size_t)HALF * g.ldb * 2;
    const size_t tstepA = 2 * hstepA, tstepB = 2 * hstepB;
    const unsigned ldsw = (unsigned)wid * 1024u;
    const int aoff = lds_byte(wr * 64 + fr, fq * 8), boff = lds_byte(wc * 32 + fr, fq * 8);
#define PG8_SA(b, h) (((b) * 2 + (h)) * HTB)
#define PG8_SB(b, h) ((4 + (b) * 2 + (h)) * HTB)
#define PG8_STAGE(bufoff, gbase, voff) do { _Pragma("unroll") for (int _i = 0; _i < 2; ++_i) \
        __builtin_amdgcn_global_load_lds((const unsigned*)((const char*)(gbase) + (voff)[_i]), (LAS unsigned*)(lds + (bufoff) + ldsw + _i * 8192), 16, 0, 0); } while (0)
#define PG8_LDA(dst, b, h) do { _Pragma("unroll") for (int m = 0; m < 4; ++m) _Pragma("unroll") for (int k = 0; k < 2; ++k) dst[m][k] = *(const LAS bf16x8*)(lds + PG8_SA(b, h) + aoff + m * 2048 + k * 1024); } while (0)
#define PG8_LDB(dst, b, h) do { _Pragma("unroll") for (int n = 0; n < 2; ++n) _Pragma("unroll") for (int k = 0; k < 2; ++k) dst[n][k] = *(const LAS bf16x8*)(lds + PG8_SB(b, h) + boff + n * 2048 + k * 1024); } while (0)
#define PG8_MMA(ai, bj, At, Bt) do { __builtin_amdgcn_s_setprio(1); _Pragma("unroll") for (int m = 0; m < 4; ++m) _Pragma("unroll") for (int n = 0; n < 2; ++n) _Pragma("unroll") for (int k = 0; k < 2; ++k) \
        acc[ai][bj][m][n] = __builtin_amdgcn_mfma_f32_16x16x32_bf16(Bt[n][k], At[m][k], acc[ai][bj][m][n], 0, 0, 0); __builtin_amdgcn_s_setprio(0); } while (0)
#define PG8_WAIT_V(n) asm volatile("s_waitcnt vmcnt(" #n ")" ::: "memory")
#define PG8_WAIT_L(n) asm volatile("s_waitcnt lgkmcnt(" #n ")" ::: "memory")
#define PG8_BAR __builtin_amdgcn_s_barrier()
#define PG8_SCHED __builtin_amdgcn_sched_barrier(0)
    Unit cur, nxt; int ui = 0;
    if (!S.next(0, cur)) return;
    f32x4 acc[2][2][4][2];
#pragma unroll
    for (int a = 0; a < 2; ++a)
#pragma unroll
        for (int b = 0; b < 2; ++b)
#pragma unroll
            for (int m = 0; m < 4; ++m)
#pragma unroll
                for (int n = 0; n < 2; ++n) acc[a][b][m][n] = (f32x4){0.f, 0.f, 0.f, 0.f};
    bf16x8 At[4][2], B0[2][2], B1[2][2];
    const char* cA = (const char*)g.A + (size_t)cur.pm * tstepA; const char* cB = (const char*)g.Bt + (size_t)cur.pn * tstepB;
    PG8_STAGE(PG8_SB(0, 0), cB, voffB); PG8_STAGE(PG8_SB(0, 1), cB + hstepB, voffB); PG8_STAGE(PG8_SA(0, 0), cA, voffA); PG8_STAGE(PG8_SA(0, 1), cA + hstepA, voffA);
    if (wr == 1) PG8_BAR;
    PG8_WAIT_V(2); PG8_BAR;
    PG8_STAGE(PG8_SB(1, 0), cB + kstep, voffB); PG8_STAGE(PG8_SA(1, 0), cA + kstep, voffA); PG8_STAGE(PG8_SB(1, 1), cB + hstepB + kstep, voffB);
    PG8_WAIT_V(6); PG8_BAR;
    for (;;) {
        const bool has_next = S.next(ui + 1, nxt);
        const char* nA = has_next ? (const char*)g.A + (size_t)nxt.pm * tstepA : cA; const char* nB = has_next ? (const char*)g.Bt + (size_t)nxt.pn * tstepB : cB;
        for (int t = 0; t < nt; t += 2) {
            const bool last = (t == nt - 2);
            const char* a1 = cA + (size_t)(t + 1) * kstep;
            const char* a2 = last ? nA : cA + (size_t)(t + 2) * kstep; const char* b2 = last ? nB : cB + (size_t)(t + 2) * kstep;
            const char* a3 = a2 + kstep; const char* b3 = b2 + kstep;
            PG8_LDB(B0, 0, 0); PG8_LDB(B1, 0, 1); PG8_SCHED; PG8_LDA(At, 0, 0); PG8_STAGE(PG8_SA(1, 1), a1 + hstepA, voffA);
            PG8_WAIT_V(8); PG8_WAIT_L(0); PG8_BAR; PG8_MMA(0, 0, At, B0); PG8_MMA(0, 1, At, B1); PG8_BAR; PG8_SCHED;
            PG8_LDA(At, 0, 1); PG8_STAGE(PG8_SB(0, 0), b2, voffB); PG8_STAGE(PG8_SB(0, 1), b2 + hstepB, voffB); PG8_STAGE(PG8_SA(0, 0), a2, voffA);
            PG8_WAIT_V(8); PG8_WAIT_L(0); PG8_BAR; PG8_MMA(1, 0, At, B0); PG8_MMA(1, 1, At, B1); PG8_BAR; PG8_SCHED;
            PG8_LDB(B0, 1, 0); PG8_LDB(B1, 1, 1); PG8_SCHED; PG8_LDA(At, 1, 0); PG8_STAGE(PG8_SA(0, 1), a2 + hstepA, voffA);
            PG8_WAIT_V(8); PG8_WAIT_L(0); PG8_BAR; PG8_MMA(0, 0, At, B0); PG8_MMA(0, 1, At, B1); PG8_BAR; PG8_SCHED;
            PG8_LDA(At, 1, 1); PG8_STAGE(PG8_SB(1, 0), b3, voffB); PG8_STAGE(PG8_SB(1, 1), b3 + hstepB, voffB); PG8_STAGE(PG8_SA(1, 0), a3, voffA);
            PG8_WAIT_V(8); PG8_WAIT_L(0); PG8_BAR; PG8_MMA(1, 0, At, B0); PG8_MMA(1, 1, At, B1); PG8_BAR; PG8_SCHED;
        }
        if constexpr (ALIGN_EPI) { if (wr == 0) PG8_BAR; }
        { int fr_ = fr, fq_ = fq; asm volatile("" : "+v"(fr_), "+v"(fq_)); E(acc, cur, wr, wc, fr_, fq_); }
        if (!has_next) break;
#pragma unroll
        for (int a = 0; a < 2; ++a)
#pragma unroll
            for (int b = 0; b < 2; ++b)
#pragma unroll
                for (int m = 0; m < 4; ++m)
#pragma unroll
                    for (int n = 0; n < 2; ++n) acc[a][b][m][n] = (f32x4){0.f, 0.f, 0.f, 0.f};
        cur = nxt; cA = nA; cB = nB; ++ui;
        if constexpr (ALIGN_EPI) { if (wr == 1) PG8_BAR; }
    }
    PG8_WAIT_V(0);
    if constexpr (!ALIGN_EPI) { if (wr == 0) PG8_BAR; }
    PG8_BAR;
#undef PG8_SA
#undef PG8_SB
#undef PG8_STAGE
#undef PG8_LDA
#undef PG8_LDB
#undef PG8_MMA
#undef PG8_WAIT_V
#undef PG8_WAIT_L
#undef PG8_BAR
#undef PG8_SCHED
}

typedef f32x4 Acc[2][2][4][2];

struct EpiStoreBf16 { static constexpr bool PERM = true; bf16_t* O; int ldc;
    __device__ __forceinline__ void operator()(const Acc& acc, const Unit& u, int wr, int wc, int fr, int fq) const {
        const int row0 = u.pm * BM + wr * 64 + fr, col0 = u.pn * BM + wc * 32 + 8 * fq;
#pragma unroll
        for (int ai = 0; ai < 2; ++ai)
#pragma unroll
            for (int m = 0; m < 4; ++m) { bf16_t* rowp = O + (size_t)(row0 + ai * HALF + m * 16) * ldc + col0;
#pragma unroll
                for (int bj = 0; bj < 2; ++bj) *(GAS u32x4*)(rowp + bj * HALF) = pack8(acc[ai][bj][m][0], acc[ai][bj][m][1]); }
    }
};
__device__ __forceinline__ void rstd8_from_ssp(const float* ssp, int row0, int fq, float (&rs)[2][4]) {
    f32x4 p[2][4];
#pragma unroll
    for (int ai = 0; ai < 2; ++ai)
#pragma unroll
        for (int m = 0; m < 4; ++m) p[ai][m] = *(const GAS f32x4*)(ssp + (size_t)(row0 + ai * 128 + m * 16) * 16 + 4 * fq);
#pragma unroll
    for (int ai = 0; ai < 2; ++ai)
#pragma unroll
        for (int m = 0; m < 4; ++m) { float v = (p[ai][m][0] + p[ai][m][1]) + (p[ai][m][2] + p[ai][m][3]); v += __shfl_xor(v, 16); v += __shfl_xor(v, 32); rs[ai][m] = rsqrtf(v * (1.0f / DM) + EPS); }
}
struct EpiSwiGLU { static constexpr bool PERM = true; bf16_t* O; const float* ssp; const float* shw;
    __device__ __forceinline__ void operator()(const Acc& acc, const Unit& u, int wr, int wc, int fr, int fq) const {
        const int row0 = u.pm * BM + wr * 64 + fr, col0 = u.pn * HALF + wc * 32 + 8 * fq, b = u.pm >> 5;
        f32x4 sg[2], su[2];
#pragma unroll
        for (int n = 0; n < 2; ++n) { sg[n] = *(const GAS f32x4*)(shw + (size_t)b * (2 * FF) + col0 + 4 * n); su[n] = *(const GAS f32x4*)(shw + (size_t)b * (2 * FF) + FF + col0 + 4 * n); }
        float rs8[2][4]; rstd8_from_ssp(ssp, row0, fq, rs8);
#pragma unroll
        for (int ai = 0; ai < 2; ++ai)
#pragma unroll
            for (int m = 0; m < 4; ++m) { const int row = row0 + ai * HALF + m * 16; const float rs = rs8[ai][m];
                bf16_t* rowp = O + (size_t)row * FF + col0;
                f32x4 o[2];
#pragma unroll
                for (int n = 0; n < 2; ++n)
#pragma unroll
                    for (int e = 0; e < 4; ++e) { const float gg = acc[ai][0][m][n][e] * rs + sg[n][e], uu = acc[ai][1][m][n][e] * rs + su[n][e]; o[n][e] = gg * fast_sigmoid(gg) * uu; }
                *(GAS u32x4*)rowp = pack8(o[0], o[1]);
                asm volatile("" ::: "memory"); }
    }
};
struct EpiProj { static constexpr bool PERM = true; bf16_t* O; const float* ssp; const float* shw;
    __device__ __forceinline__ void operator()(const Acc& acc, const Unit& u, int wr, int wc, int fr, int fq) const {
        const int row0 = u.pm * BM + wr * 64 + fr, col0 = u.pn * BM + wc * 32 + 8 * fq, b = u.pm >> 5;
        float rs8[2][4]; rstd8_from_ssp(ssp, row0, fq, rs8);
#pragma unroll
        for (int ai = 0; ai < 2; ++ai)
#pragma unroll
            for (int m = 0; m < 4; ++m) { const int row = row0 + ai * HALF + m * 16; const float rs = rs8[ai][m];
                bf16_t* rowp = O + (size_t)row * PROJ_LD + col0;
#pragma unroll
                for (int bj = 0; bj < 2; ++bj) { const f32x4 h0 = *(const GAS f32x4*)(shw + (size_t)b * PROJ_LD + col0 + bj * HALF), h1 = *(const GAS f32x4*)(shw + (size_t)b * PROJ_LD + col0 + bj * HALF + 4);
                    *(GAS u32x4*)(rowp + bj * HALF) = pack8(acc[ai][bj][m][0] * rs + h0, acc[ai][bj][m][1] * rs + h1); }
                asm volatile("" ::: "memory"); }
    }
};
template <int MODE> struct EpiResidN { static constexpr bool PERM = true; const void* base; void* xout; bf16_t* xa; float* ssp; const float* gate; const float* avec; float s;
    __device__ __forceinline__ void operator()(const Acc& acc, const Unit& u, int wr, int wc, int fr, int fq) const {
        const int row0 = u.pm * BM + wr * 64 + fr, col0 = u.pn * BM + wc * 32 + 8 * fq, b = u.pm >> 5;
        float ss[2][4];
#pragma unroll
        for (int ai = 0; ai < 2; ++ai)
#pragma unroll
            for (int m = 0; m < 4; ++m) ss[ai][m] = 0.f;
#pragma unroll
        for (int bj = 0; bj < 2; ++bj) { const int c = col0 + bj * HALF;
            const f32x4 g0 = *(const GAS f32x4*)(gate + (size_t)b * MODLD + c) * s, g1 = *(const GAS f32x4*)(gate + (size_t)b * MODLD + c + 4) * s;
            f32x4 a0 = {0.f, 0.f, 0.f, 0.f}, a1 = {0.f, 0.f, 0.f, 0.f};
            if (MODE < 2) { a0 = *(const GAS f32x4*)(avec + (size_t)b * DM + c); a1 = *(const GAS f32x4*)(avec + (size_t)b * DM + c + 4); }
            constexpr int NB = MODE == 0 ? 2 : 4;
#pragma unroll
            for (int r0 = 0; r0 < 8; r0 += NB) {
                f32x4 bf[NB][2]; u32x4 bw[NB];
#pragma unroll
                for (int q = 0; q < NB; ++q) { const int ai = (r0 + q) >> 2, m = (r0 + q) & 3; const size_t off = (size_t)(row0 + ai * HALF + m * 16) * DM + c;
                    if (MODE == 0) { bf[q][0] = *(const GAS f32x4*)((const float*)base + off); bf[q][1] = *(const GAS f32x4*)((const float*)base + off + 4); }
                    else bw[q] = *(const GAS u32x4*)((const bf16_t*)base + off); }
#pragma unroll
                for (int q = 0; q < NB; ++q) { const int ai = (r0 + q) >> 2, m = (r0 + q) & 3; const size_t off = (size_t)(row0 + ai * HALF + m * 16) * DM + c;
                    f32x4 b0, b1;
                    if (MODE == 0) { b0 = bf[q][0]; b1 = bf[q][1]; }
                    else { const u32x4 w = bw[q]; b0 = (f32x4){bf_lo(w.x), bf_hi(w.x), bf_lo(w.y), bf_hi(w.y)}; b1 = (f32x4){bf_lo(w.z), bf_hi(w.z), bf_lo(w.w), bf_hi(w.w)}; }
                    const f32x4 o0 = b0 + g0 * acc[ai][bj][m][0], o1 = b1 + g1 * acc[ai][bj][m][1];
                    if (MODE == 2) { *(GAS f32x4*)((float*)xout + off) = o0; *(GAS f32x4*)((float*)xout + off + 4) = o1; }
                    else { *(GAS u32x4*)((bf16_t*)xout + off) = pack8(o0, o1); *(GAS u32x4*)(xa + off) = pack8(o0 * a0, o1 * a1);
                        const f32x4 q0 = o0 * o0, q1 = o1 * o1; ss[ai][m] += ((q0[0] + q0[1]) + (q0[2] + q0[3])) + ((q1[0] + q1[1]) + (q1[2] + q1[3])); } }
                asm volatile("" ::: "memory");
            }
        }
        if (MODE < 2) {
#pragma unroll
            for (int ai = 0; ai < 2; ++ai)
#pragma unroll
                for (int m = 0; m < 4; ++m) { float v = ss[ai][m]; v += __shfl_xor(v, 16); v += __shfl_xor(v, 32);
                    if (fq == 0) ((GAS float*)ssp)[(size_t)(row0 + ai * HALF + m * 16) * 16 + u.pn * 4 + wc] = v; }
        }
    }
};
struct EpiVT { static constexpr bool PERM = true; bf16_t* O; const float* rstd;
    __device__ __forceinline__ void operator()(const Acc& acc, const Unit& u, int wr, int wc, int fr, int fq) const {
        const int row0 = u.pm * BM + wr * 64 + fr, col0 = u.pn * BM + wc * 32 + 8 * fq;
#pragma unroll
        for (int ai = 0; ai < 2; ++ai)
#pragma unroll
            for (int m = 0; m < 4; ++m) { bf16_t* rowp = O + (size_t)(row0 + ai * HALF + m * 16) * T + col0;
#pragma unroll
                for (int bj = 0; bj < 2; ++bj) *(GAS u32x4*)(rowp + bj * HALF) = pack8(acc[ai][bj][m][0], acc[ai][bj][m][1]); }
    }
};
template <int ROPE_TILE> struct EpiQK { static constexpr bool PERM = true; bf16_t* O; int ldo, hw; const float* rstd; const float* wn; const float* wrp; const float* cosT; const float* sinT; float c2;
    __device__ __forceinline__ void operator()(const Acc& acc, const Unit& u, int wr, int wc, int fr, int fq) const {
        const int row0 = u.pm * BM + wr * 64 + fr;
        const float* wn = this->wn; const float* wrp = this->wrp;
        asm volatile("" : "+s"(wn), "+s"(wrp));
        if (ROPE_TILE < 0 || u.pn != ROPE_TILE) {
            const int head = 4 * u.pn + wc;
#pragma unroll
            for (int ai = 0; ai < 2; ++ai)
#pragma unroll
                for (int m = 0; m < 4; ++m) { const int row = row0 + ai * HALF + m * 16; const float rs = 1.0f;
                    float ss = 0.f;
#pragma unroll
                    for (int bj = 0; bj < 2; ++bj)
#pragma unroll
                        for (int n = 0; n < 2; ++n) { const f32x4 q = acc[ai][bj][m][n] * acc[ai][bj][m][n]; ss += (q[0] + q[1]) + (q[2] + q[3]); }
                    ss += __shfl_xor(ss, 16); ss += __shfl_xor(ss, 32);
                    const float f = rs * rsqrtf(ss * rs * rs * (1.0f / 64.0f) + EPS) * c2;
                    bf16_t* rowp = O + (size_t)row * ldo + head * hw + 8 * fq;
#pragma unroll
                    for (int bj = 0; bj < 2; ++bj) { const f32x4 w0 = *(const GAS f32x4*)(wn + 32 * bj + 8 * fq), w1 = *(const GAS f32x4*)(wn + 32 * bj + 8 * fq + 4);
                        *(GAS u32x4*)(rowp + 32 * bj) = pack8(acc[ai][bj][m][0] * f * w0, acc[ai][bj][m][1] * f * w1); }
                    asm volatile("" ::: "memory"); }
        } else {
            const float sgn = (fq < 2) ? -1.0f : 1.0f;
#pragma unroll
            for (int ai = 0; ai < 2; ++ai)
#pragma unroll
                for (int m = 0; m < 4; ++m) { const int row = row0 + ai * HALF + m * 16; const float rs = 1.0f;
#pragma unroll
                    for (int bj = 0; bj < 2; ++bj) { float ss = 0.f;
#pragma unroll
                        for (int n = 0; n < 2; ++n) { const f32x4 q = acc[ai][bj][m][n] * acc[ai][bj][m][n]; ss += (q[0] + q[1]) + (q[2] + q[3]); }
                        ss += __shfl_xor(ss, 16); ss += __shfl_xor(ss, 32);
                        const float f = rs * rsqrtf(ss * rs * rs * (1.0f / 32.0f) + EPS);
#pragma unroll
                        for (int n = 0; n < 2; ++n) { const f32x4 w = *(const GAS f32x4*)(wrp + 8 * fq + 4 * n);
                            const f32x4 cs = *(const GAS f32x4*)(cosT + (size_t)row * 16 + 8 * (fq & 1) + 4 * n), sn = *(const GAS f32x4*)(sinT + (size_t)row * 16 + 8 * (fq & 1) + 4 * n);
                            f32x4 o;
#pragma unroll
                            for (int e = 0; e < 4; ++e) { const float y = acc[ai][bj][m][n][e] * f * w[e]; const float pt = __shfl_xor(y, 32); o[e] = (y * cs[e] + sgn * pt * sn[e]) * c2; }
                            *(GAS u32x2*)(O + (size_t)row * ldo + (4 * bj + wc) * hw + 64 + 8 * fq + 4 * n) = (u32x2){cvt_pk_bf16(o[0], o[1]), cvt_pk_bf16(o[2], o[3])}; } }
                    asm volatile("" ::: "memory"); }
        }
    }
};
template <bool FIRST> struct EpiBranch { static constexpr bool PERM = true; bf16_t* O; const bf16_t* GL;
    __device__ __forceinline__ void operator()(const Acc& acc, const Unit& u, int wr, int wc, int fr, int fq) const {
        const int row0 = u.pm * BM + wr * 64 + fr, col0 = u.pn * BM + wc * 32 + 8 * fq;
#pragma unroll
        for (int ai = 0; ai < 2; ++ai)
#pragma unroll
            for (int m = 0; m < 4; ++m) { const size_t row = (size_t)(row0 + ai * HALF + m * 16);
#pragma unroll
                for (int bj = 0; bj < 2; ++bj) { const int c = col0 + bj * HALF;
                    const u32x4 gw = *(const GAS u32x4*)(GL + row * PROJ_LD + c);
                    f32x4 g0 = {bf_lo(gw.x), bf_hi(gw.x), bf_lo(gw.y), bf_hi(gw.y)}, g1 = {bf_lo(gw.z), bf_hi(gw.z), bf_lo(gw.w), bf_hi(gw.w)};
                    f32x4 o0, o1;
#pragma unroll
                    for (int e = 0; e < 4; ++e) { o0[e] = fast_sigmoid(g0[e]) * acc[ai][bj][m][0][e]; o1[e] = fast_sigmoid(g1[e]) * acc[ai][bj][m][1][e]; }
                    bf16_t* op = O + row * DM + c;
                    if (!FIRST) { const u32x4 ow = *(const GAS u32x4*)op;
                        o0 += (f32x4){bf_lo(ow.x), bf_hi(ow.x), bf_lo(ow.y), bf_hi(ow.y)}; o1 += (f32x4){bf_lo(ow.z), bf_hi(ow.z), bf_lo(ow.w), bf_hi(ow.w)}; }
                    *(GAS u32x4*)op = pack8(o0, o1); } }
    }
};
}

namespace att {
constexpr int KROW = 208, VROW = 144, KBUF = 64 * KROW, VBUF = 64 * VROW, V_OFF = 4 * KBUF;
constexpr float THR = 8.0f;
#define ATT_SB() __builtin_amdgcn_sched_barrier(0)
#define ATT_E(i) ((i) < 16 ? e0[(i) & 15] : e1[(i) & 15])
__device__ __forceinline__ float rowmax32(const f32x16& a, const f32x16& b) {
    float x = fmaxf(fmaxf(a[0], a[1]), b[0]), y = fmaxf(fmaxf(a[2], a[3]), b[1]); x = fmaxf(fmaxf(x, b[2]), b[3]);
#pragma unroll
    for (int r = 4; r < 16; r += 4) { x = fmaxf(fmaxf(x, a[r]), a[r + 1]); y = fmaxf(fmaxf(y, a[r + 2]), a[r + 3]); x = fmaxf(fmaxf(x, b[r]), b[r + 1]); y = fmaxf(fmaxf(y, b[r + 2]), b[r + 3]); }
    return fmaxf(x, y);
}
__device__ __forceinline__ void cmask(f32x16& p0, f32x16& p1, int kv0, int qidx, int hi) {
#pragma unroll
    for (int r = 0; r < 16; ++r) { const int kv = kv0 + (r & 3) + 8 * (r >> 2) + 4 * hi; if (kv > qidx) p0[r] = -INFINITY; if (kv + 32 > qidx) p1[r] = -INFINITY; }
}
template <int P> __device__ __forceinline__ void tile_iter(LAS unsigned char* lds, const int jt, const int NT, const int jmax, const int q0, const int qidx, const int hi,
        const unsigned ka, const unsigned va, const bf16_t* kn_src, const bf16_t* kr_src, const bf16_t* vt_src, const unsigned kn_dst, const unsigned kr_dst, const unsigned vt_dst, const bool has_r,
        const bf16x8 (&qr)[6], f32x16& o0, f32x16& o1, f32x16& negm, f32x16& s0, f32x16& s1, f32x16& e0, f32x16& e1, float& m_run, float& l_run,
        u32x4 (&gK)[2], u32x4 (&gR)[2], u32x4 (&gV)[2]) {
        { const unsigned nk = ((jt + 3) & 3) * KBUF, nv = ((jt + 2) & 3) * VBUF;
          *(LAS u32x4*)(lds + nk + kn_dst) = gK[P]; *(LAS u32x4*)(lds + nk + kr_dst) = gR[P];
          *(LAS u32x2*)(lds + nv + vt_dst) = (u32x2){gV[P].x, gV[P].y}; *(LAS u32x2*)(lds + nv + vt_dst + 16) = (u32x2){gV[P].z, gV[P].w};
          const int tk = (jt + 5 < NT) ? jt + 5 : NT - 1, tv = (jt + 4 < NT) ? jt + 4 : NT - 1;
          gK[P] = *(const GAS u32x4*)(kn_src + (size_t)tk * 64 * 512); gR[P] = *(const GAS u32x4*)(kr_src + (size_t)tk * 64 * 32); gV[P] = *(const GAS u32x4*)(vt_src + (size_t)tv * 64); }
        if (jt <= jmax) {
            const bool nx = jt + 1 <= jmax;
            const unsigned kb = ((jt + 1) & 3) * KBUF + ka, vb = (jt & 3) * VBUF + va;
            u32x4 pf[4]; float sacc = 0.f;
            {
                bf16x8 kf0 = *(const LAS bf16x8*)(lds + kb), kf1 = *(const LAS bf16x8*)(lds + kb + 32 * KROW), kn0 = kf0, kn1 = kf1;
#pragma unroll
                for (int ks = 0; ks < 6; ++ks) {
                    if (ks < 5) { kn0 = *(const LAS bf16x8*)(lds + kb + (ks + 1) * 32); kn1 = *(const LAS bf16x8*)(lds + kb + 32 * KROW + (ks + 1) * 32); }
                    s0 = __builtin_amdgcn_mfma_f32_32x32x16_bf16(kf0, qr[ks], ks == 0 ? negm : s0, 0, 0, 0);
#pragma unroll
                    for (int i = (16 * ks) / 3; i < (16 * ks + 8) / 3; ++i) sacc += ATT_E(i);
#pragma unroll
                    for (int c = (8 * ks) / 3; c < (8 * ks + 4) / 3; ++c) pf[c >> 2][c & 3] = cvt_pk_bf16(ATT_E(2 * c), ATT_E(2 * c + 1));
                    ATT_SB();
                    s1 = __builtin_amdgcn_mfma_f32_32x32x16_bf16(kf1, qr[ks], ks == 0 ? negm : s1, 0, 0, 0);
#pragma unroll
                    for (int i = (16 * ks + 8) / 3; i < (16 * ks + 16) / 3; ++i) sacc += ATT_E(i);
#pragma unroll
                    for (int c = (8 * ks + 4) / 3; c < (8 * ks + 8) / 3; ++c) pf[c >> 2][c & 3] = cvt_pk_bf16(ATT_E(2 * c), ATT_E(2 * c + 1));
                    ATT_SB();
                    kf0 = kn0; kf1 = kn1;
                }
            }
            l_run += sacc;
            float fsc = 1.0f; bool resc = false;
            if (nx) {
                const int kv0 = (jt + 1) * 64;
                if (kv0 + 63 > q0) cmask(s0, s1, kv0, qidx, hi);
                float rm = rowmax32(s0, s1);
                if (__any(rm > THR)) {
                    rm = fmaxf(rm, __shfl_xor(rm, 32));
                    const float dl = fmaxf(rm, 0.f);
                    m_run += dl; fsc = __builtin_amdgcn_exp2f(-dl); l_run *= fsc; resc = true;
#pragma unroll
                    for (int r = 0; r < 16; ++r) { s0[r] -= dl; s1[r] -= dl; negm[r] = -m_run; }
                }
            }
            ATT_SB();
            {
#define ATT_VA(m) (vb + ((m) & 1) * 32 * VROW + ((m) >> 1) * 32)
                bf16x8 vq[3];
                vq[0] = *(const LAS bf16x8*)(lds + ATT_VA(0)); vq[1] = *(const LAS bf16x8*)(lds + ATT_VA(1));
#pragma unroll
                for (int m = 0; m < 8; ++m) {
                    if (m < 6) vq[(m + 2) % 3] = *(const LAS bf16x8*)(lds + ATT_VA(m + 2));
                    const bf16x8 vf = vq[m % 3];
                    const bf16x8 pb = __builtin_bit_cast(bf16x8, pf[m >> 1]);
                    if ((m & 1) == 0) o0 = __builtin_amdgcn_mfma_f32_32x32x16_bf16(vf, pb, o0, 0, 0, 0);
                    else o1 = __builtin_amdgcn_mfma_f32_32x32x16_bf16(vf, pb, o1, 0, 0, 0);
                    if (m < 4) {
#pragma unroll
                        for (int i = 4 * m; i < 4 * m + 4; ++i) e0[i] = __builtin_amdgcn_exp2f(s0[i]);
                        asm volatile("" : "+v"(e0));
                    } else {
#pragma unroll
                        for (int i = 4 * m - 16; i < 4 * m - 12; ++i) e1[i] = __builtin_amdgcn_exp2f(s1[i]);
                        asm volatile("" : "+v"(e1));
                    }
                    ATT_SB();
                }
#undef ATT_VA
            }
            if (resc) {
#pragma unroll
                for (int r = 0; r < 16; ++r) { o0[r] *= fsc; o1[r] *= fsc; }
            }
        }
        if (P == 1) __syncthreads();
}
__device__ __forceinline__ void unit(LAS unsigned char* lds, int b, int h, int qb, const bf16_t* Q, const bf16_t* KN, const bf16_t* KR, const bf16_t* VT, bf16_t* O) {
    const int tid = opq_tid(), lane = tid & 63, wid = __builtin_amdgcn_readfirstlane(tid >> 6), r32 = lane & 31, hi = lane >> 5;
    const size_t tok0 = (size_t)b * SEQ;
    const int q0 = qb * 256 + wid * 32, qidx = q0 + r32, NT = 4 * (qb + 1), jmax = (q0 + 31) >> 6;
    bf16x8 qr[6];
    { const bf16_t* qp = Q + (tok0 + qidx) * QLD + h * 96 + hi * 8;
#pragma unroll
      for (int ks = 0; ks < 6; ++ks) qr[ks] = *(const GAS bf16x8*)(qp + ks * 16); }
    const int krow = tid >> 3, kch = tid & 7, rrow = (tid >> 2) & 63, rch = tid & 3;
    const bf16_t* kn_src = KN + (tok0 + krow) * 512 + h * 64 + kch * 8;
    const bf16_t* kr_src = KR + (tok0 + rrow) * 32 + rch * 8;
    const bf16_t* vt_src = VT + (size_t)(h * 64 + krow) * T + tok0 + kch * 8;
    const unsigned kn_dst = krow * KROW + kch * 16, kr_dst = rrow * KROW + 128 + rch * 16, vt_dst = V_OFF + krow * VROW + (kch >> 1) * 32 + (kch & 1) * 8;
    const bool has_r = tid < 256;
    u32x4 gk, gr = {0u, 0u, 0u, 0u}, gv;
    u32x4 gK[2], gR[2], gV[2];
    gK[0] = gr; gK[1] = gr; gR[0] = gr; gR[1] = gr; gV[0] = gr; gV[1] = gr;
    {
        gk = *(const GAS u32x4*)kn_src; gr = *(const GAS u32x4*)kr_src; gv = *(const GAS u32x4*)vt_src;
        const u32x4 gk1 = *(const GAS u32x4*)(kn_src + (size_t)64 * 512), gr1 = *(const GAS u32x4*)(kr_src + (size_t)64 * 32), gv1 = *(const GAS u32x4*)(vt_src + 64);
        const u32x4 gk2 = *(const GAS u32x4*)(kn_src + (size_t)2 * 64 * 512), gr2 = *(const GAS u32x4*)(kr_src + (size_t)2 * 64 * 32);
        gK[0] = *(const GAS u32x4*)(kn_src + (size_t)3 * 64 * 512); gR[0] = *(const GAS u32x4*)(kr_src + (size_t)3 * 64 * 32); gV[0] = *(const GAS u32x4*)(vt_src + (size_t)2 * 64);
        { const int t4 = NT > 4 ? 4 : 3; gK[1] = *(const GAS u32x4*)(kn_src + (size_t)t4 * 64 * 512); gR[1] = *(const GAS u32x4*)(kr_src + (size_t)t4 * 64 * 32); gV[1] = *(const GAS u32x4*)(vt_src + (size_t)3 * 64); }
        *(LAS u32x4*)(lds + kn_dst) = gk; *(LAS u32x4*)(lds + kr_dst) = gr;
        *(LAS u32x2*)(lds + vt_dst) = (u32x2){gv.x, gv.y}; *(LAS u32x2*)(lds + vt_dst + 16) = (u32x2){gv.z, gv.w};
        *(LAS u32x4*)(lds + KBUF + kn_dst) = gk1; *(LAS u32x4*)(lds + KBUF + kr_dst) = gr1;
        *(LAS u32x2*)(lds + VBUF + vt_dst) = (u32x2){gv1.x, gv1.y}; *(LAS u32x2*)(lds + VBUF + vt_dst + 16) = (u32x2){gv1.z, gv1.w};
        *(LAS u32x4*)(lds + 2 * KBUF + kn_dst) = gk2; *(LAS u32x4*)(lds + 2 * KBUF + kr_dst) = gr2;
    }
    __syncthreads();
    const unsigned ka = r32 * KROW + hi * 16;
    const unsigned va = V_OFF + r32 * VROW + hi * 16;
    f32x16 o0, o1, negm, s0, s1, e0, e1;
#pragma unroll
    for (int r = 0; r < 16; ++r) { o0[r] = 0.f; o1[r] = 0.f; s0[r] = 0.f; s1[r] = 0.f; }
    float m_run, l_run = 0.f;
    {
#pragma unroll
        for (int ks = 0; ks < 6; ++ks) {
            const bf16x8 k0 = *(const LAS bf16x8*)(lds + ka + ks * 32), k1 = *(const LAS bf16x8*)(lds + ka + 32 * KROW + ks * 32);
            s0 = __builtin_amdgcn_mfma_f32_32x32x16_bf16(k0, qr[ks], s0, 0, 0, 0);
            s1 = __builtin_amdgcn_mfma_f32_32x32x16_bf16(k1, qr[ks], s1, 0, 0, 0);
        }
        if (63 > q0) cmask(s0, s1, 0, qidx, hi);
        float rm = rowmax32(s0, s1); rm = fmaxf(rm, __shfl_xor(rm, 32));
        m_run = rm;
#pragma unroll
        for (int r = 0; r < 16; ++r) { e0[r] = __builtin_amdgcn_exp2f(s0[r] - rm); e1[r] = __builtin_amdgcn_exp2f(s1[r] - rm); negm[r] = -rm; }
    }
    __syncthreads();
    for (int jt = 0; jt < NT; jt += 2) {
        tile_iter<0>(lds, jt, NT, jmax, q0, qidx, hi, ka, va, kn_src, kr_src, vt_src, kn_dst, kr_dst, vt_dst, has_r, qr, o0, o1, negm, s0, s1, e0, e1, m_run, l_run, gK, gR, gV);
        tile_iter<1>(lds, jt + 1, NT, jmax, q0, qidx, hi, ka, va, kn_src, kr_src, vt_src, kn_dst, kr_dst, vt_dst, has_r, qr, o0, o1, negm, s0, s1, e0, e1, m_run, l_run, gK, gR, gV);
    }
    const float lt = l_run + __shfl_xor(l_run, 32);
    const float inv = 1.0f / lt;
    bf16_t* op = O + (tok0 + qidx) * 512 + h * 64 + 4 * hi;
#pragma unroll
    for (int g = 0; g < 4; ++g) {
        *(GAS u32x2*)(op + 8 * g) = (u32x2){cvt_pk_bf16(o0[4 * g] * inv, o0[4 * g + 1] * inv), cvt_pk_bf16(o0[4 * g + 2] * inv, o0[4 * g + 3] * inv)};
        *(GAS u32x2*)(op + 32 + 8 * g) = (u32x2){cvt_pk_bf16(o1[4 * g] * inv, o1[4 * g + 1] * inv), cvt_pk_bf16(o1[4 * g + 2] * inv, o1[4 * g + 3] * inv)};
    }
}
__device__ __forceinline__ void phase(LAS unsigned char* lds, const bf16_t* Q, const bf16_t* KN, const bf16_t* KR, const bf16_t* VT, bf16_t* O) {
    for (int j = blockIdx.x; j < 2048; j += gridDim.x) {
        const int bh = j & 63, qslot = j >> 6, k = qslot >> 2, s = qslot & 3, i = k >> 1;
        const int qb = (k & 1) ? 31 - (4 * i + s) : 4 * i + s;
        unit(lds, bh >> 3, bh & 7, qb, Q, KN, KR, VT, O);
    }
}
#undef ATT_SB
#undef ATT_E
}

__device__ __forceinline__ int src_col(int map, int n0) {
    const int pn = n0 >> 8, bj = (n0 >> 7) & 1, wc = (n0 >> 5) & 3;
    switch (map) {
        case 1: return bj * FF + 128 * pn + (n0 & 127);
        case 2: return pn < 2 ? 96 * (4 * pn + wc) + 32 * bj : 96 * (4 * bj + wc) + 64;
        case 3: return 128 * (4 * pn + wc) + 32 * bj;
        case 4: return 128 * (n0 >> 6) + 64 + (n0 & 63);
        case 5: return n0 < 4000 ? n0 : -1;
        default: return n0;
    }
}
__device__ __forceinline__ void tr_item(const float* W, int K, int pitch, bf16_t* WT, const float* scale, int map, int nblk, LAS float* scr, int item, int lane) {
    const int kb = item / nblk, nb = item % nblk, k0 = 64 * kb, n0 = 32 * nb;
    const int sc0 = src_col(map, n0);
#pragma unroll 8
    for (int i = 0; i < 32; ++i) { const int kk = 2 * i + (lane >> 5); float v = 0.f;
        if (sc0 >= 0) { v = ((const GAS float*)W)[(size_t)(k0 + kk) * pitch + sc0 + (lane & 31)]; if (scale) v *= ((const GAS float*)scale)[k0 + kk]; }
        scr[kk * 33 + (lane & 31)] = v; }
    asm volatile("s_waitcnt lgkmcnt(0)" ::: "memory");
    const int c = lane & 7;
#pragma unroll
    for (int j = 0; j < 4; ++j) { const int n = (lane >> 3) + 8 * j; const LAS float* s = scr + (8 * c) * 33 + n;
        u32x4 o; o.x = cvt_pk_bf16(s[0 * 33], s[1 * 33]); o.y = cvt_pk_bf16(s[2 * 33], s[3 * 33]); o.z = cvt_pk_bf16(s[4 * 33], s[5 * 33]); o.w = cvt_pk_bf16(s[6 * 33], s[7 * 33]);
        *(GAS u32x4*)(WT + (size_t)(n0 + n) * K + k0 + 8 * c) = o; }
    asm volatile("s_waitcnt lgkmcnt(0)" ::: "memory");
}

struct Args { const void* in[20]; float* out; unsigned char* ws; int ph_lo, ph_hi; };

__device__ __forceinline__ void gemv64(const LAS float* sc, LAS float* red, const float* W, int pitch, int n0, int nvalid, const float* bias, float* out, int ldo, int tid) {
    const int lane = tid & 63, wid = tid >> 6, n = n0 + lane; const bool valid = n < nvalid;
    const GAS float* Wg = (const GAS float*)W + (valid ? n : 0);
    float acc[8];
#pragma unroll
    for (int b = 0; b < 8; ++b) acc[b] = 0.f;
#pragma unroll 16
    for (int kk = 0; kk < 128; ++kk) { const int k = wid * 128 + kk; const float w = Wg[(size_t)k * pitch];
#pragma unroll
        for (int b = 0; b < 8; ++b) acc[b] += sc[b * 1024 + k] * w; }
#pragma unroll
    for (int b = 0; b < 8; ++b) red[(wid * 8 + b) * 64 + lane] = acc[b];
    __syncthreads();
    { float sum = (bias && valid) ? ((const GAS float*)bias)[n] : 0.f;
#pragma unroll
      for (int w = 0; w < 8; ++w) sum += red[(w * 8 + wid) * 64 + lane];
      ((GAS float*)out)[(size_t)wid * ldo + n] = valid ? sum : 0.f; }
    __syncthreads();
}
__device__ __forceinline__ void xa_phase(const Args& A, LAS unsigned char* lds) {
    const int tid = opq_tid(), lane = tid & 63, wid = tid >> 6;
    unsigned char* ws = opq(A.ws);
    const float* mod = (const float*)(ws + WS_MOD);
    const float* normw = (const float*)A.in[5];
    {
        LAS float* sc = (LAS float*)lds; LAS float* red = (LAS float*)(lds + 32768);
        for (int it = blockIdx.x; it < 240; it += gridDim.x) {
            int sub, g; const float* W; int pitch, nvalid, ldo; float* out;
            if (it < 88) { sub = 0; g = it; W = (const float*)A.in[6]; pitch = 2 * FF; nvalid = 2 * FF; ldo = 2 * FF; out = (float*)(ws + WS_SHW0); }
            else if (it < 152) { sub = 1; g = it - 88; W = (const float*)A.in[8]; pitch = 4000; nvalid = 4000; ldo = PROJ_LD; out = (float*)(ws + WS_SHW1); }
            else { sub = 2; g = it - 152; W = (const float*)A.in[6] + (size_t)DM * 2 * FF; pitch = 2 * FF; nvalid = 2 * FF; ldo = 2 * FF; out = (float*)(ws + WS_SHW2); }
            for (int i = tid; i < 8192; i += 512) sc[i] = ((const GAS float*)mod)[(size_t)(i >> 10) * MODLD + sub * 3072 + (i & 1023)];
            __syncthreads();
            gemv64(sc, red, W, pitch, g * 64, nvalid, nullptr, out, ldo, tid);
        }
        if ((int)blockIdx.x == (int)gridDim.x - 1) {
            float* av = (float*)(ws + WS_AVEC);
            for (int i = tid; i < 2 * 8 * 1024; i += 512) { const int sb = i >> 13, b = (i >> 10) & 7, c = i & 1023;
                ((GAS float*)av)[i] = ((const GAS float*)normw)[(sb + 1) * 1024 + c] * (1.0f + ((const GAS float*)mod)[(size_t)b * MODLD + (sb + 1) * 3072 + 1024 + c]); }
        }
    }
    const float* X = (const float*)A.in[0]; bf16_t* XA = (bf16_t*)(ws + WS_H); float* ssp = (float*)(ws + WS_SSP);
    const int gw = blockIdx.x * 8 + wid, NGW = gridDim.x * 8;
    for (int ch = gw; ch < T / 32; ch += NGW) {
        const int row0 = ch * 32, b = row0 / SEQ;
        const float* scp = mod + (size_t)b * MODLD + 1024;
        f32x4 a[4];
#pragma unroll
        for (int j = 0; j < 4; ++j) { const int c = 4 * lane + 256 * j; a[j] = *(const GAS f32x4*)(normw + c) * (*(const GAS f32x4*)(scp + c) + 1.0f); }
        f32x4 vn[4];
        { const float* xr = X + (size_t)row0 * DM + 4 * lane;
#pragma unroll
          for (int j = 0; j < 4; ++j) vn[j] = *(const GAS f32x4*)(xr + 256 * j); }
        for (int r = 0; r < 32; ++r) {
            f32x4 v[4]; float ss = 0.f;
#pragma unroll
            for (int j = 0; j < 4; ++j) v[j] = vn[j];
            if (r < 31) { const float* xr = X + (size_t)(row0 + r + 1) * DM + 4 * lane;
#pragma unroll
                for (int j = 0; j < 4; ++j) vn[j] = *(const GAS f32x4*)(xr + 256 * j); }
#pragma unroll
            for (int j = 0; j < 4; ++j) { const f32x4 q = v[j] * v[j]; ss += (q[0] + q[1]) + (q[2] + q[3]); }
            ss = wave_sum(ss);
            bf16_t* hr = XA + (size_t)(row0 + r) * DM + 4 * lane;
#pragma unroll
            for (int j = 0; j < 4; ++j) { const f32x4 o = v[j] * a[j]; *(GAS u32x2*)(hr + 256 * j) = (u32x2){cvt_pk_bf16(o[0], o[1]), cvt_pk_bf16(o[2], o[3])}; }
            if (lane < 16) ((GAS float*)ssp)[(size_t)(row0 + r) * 16 + lane] = lane == 0 ? ss : 0.f;
        }
    }
}

__device__ __forceinline__ void unpack8(const u32x4 w, float (&f)[8]) { f[0] = bf_lo(w.x); f[1] = bf_hi(w.x); f[2] = bf_lo(w.y); f[3] = bf_hi(w.y); f[4] = bf_lo(w.z); f[5] = bf_hi(w.z); f[6] = bf_lo(w.w); f[7] = bf_hi(w.w); }

__device__ __forceinline__ void conv_phase(const bf16_t* P, const float* convw, const float* krw, const float* cosT, const float* sinT, float* rstdq, float* rstdkv, bf16_t* KR, bf16_t* OC) {
    const int tid = opq_tid(), lane = tid & 63, gw = blockIdx.x * 8 + (tid >> 6), NGW = gridDim.x * 8;
    float w0[8], w1[8], w2[8];
#pragma unroll
    for (int e = 0; e < 8; ++e) { w0[e] = convw[8 * lane + e]; w1[e] = convw[512 + 8 * lane + e]; w2[e] = convw[1024 + 8 * lane + e]; }
    const int kl = (lane - 48) & 3;
    float kw[8];
#pragma unroll
    for (int e = 0; e < 8; ++e) kw[e] = krw[8 * kl + e];
    for (int ch = gw; ch < T / 32; ch += NGW) {
        const int row0 = ch * 32, s0 = row0 % SEQ;
        float um2[8], um1[8];
#pragma unroll
        for (int e = 0; e < 8; ++e) { um2[e] = 0.f; um1[e] = 0.f; }
        if (s0 > 0) {
            float a[8], c[8];
            unpack8(*(const GAS u32x4*)(P + (size_t)(row0 - 2) * PROJ_LD + C_CONV + 8 * lane), a); unpack8(*(const GAS u32x4*)(P + (size_t)(row0 - 2) * PROJ_LD + C_GC + 8 * lane), c);
#pragma unroll
            for (int e = 0; e < 8; ++e) um2[e] = a[e] * c[e];
            unpack8(*(const GAS u32x4*)(P + (size_t)(row0 - 1) * PROJ_LD + C_CONV + 8 * lane), a); unpack8(*(const GAS u32x4*)(P + (size_t)(row0 - 1) * PROJ_LD + C_GC + 8 * lane), c);
#pragma unroll
            for (int e = 0; e < 8; ++e) um1[e] = a[e] * c[e];
        }
        u32x4 nxv, ngb, ngc, nst = {0u, 0u, 0u, 0u};
        { const bf16_t* pr = P + (size_t)row0 * PROJ_LD;
          nxv = *(const GAS u32x4*)(pr + C_CONV + 8 * lane); ngb = *(const GAS u32x4*)(pr + C_GB + 8 * lane); ngc = *(const GAS u32x4*)(pr + C_GC + 8 * lane);
          if (lane < 52) nst = *(const GAS u32x4*)(pr + 8 * lane); }
        for (int r = 0; r < 32; ++r) {
            const size_t row = (size_t)(row0 + r);
            float xv[8], gb[8], gc[8], st[8];
            unpack8(nxv, xv); unpack8(ngb, gb); unpack8(ngc, gc); unpack8(nst, st);
            if (r < 31) { const bf16_t* pr = P + (row + 1) * PROJ_LD;
                nxv = *(const GAS u32x4*)(pr + C_CONV + 8 * lane); ngb = *(const GAS u32x4*)(pr + C_GB + 8 * lane); ngc = *(const GAS u32x4*)(pr + C_GC + 8 * lane);
                if (lane < 52) nst = *(const GAS u32x4*)(pr + 8 * lane); }
            float o[8];
#pragma unroll
            for (int e = 0; e < 8; ++e) { const float u = gc[e] * xv[e]; o[e] = gb[e] * (w0[e] * um2[e] + w1[e] * um1[e] + w2[e] * u); um2[e] = um1[e]; um1[e] = u; }
            *(GAS u32x4*)(OC + row * 512 + 8 * lane) = (u32x4){cvt_pk_bf16(o[0], o[1]), cvt_pk_bf16(o[2], o[3]), cvt_pk_bf16(o[4], o[5]), cvt_pk_bf16(o[6], o[7])};
            float ss = 0.f;
#pragma unroll
            for (int e = 0; e < 8; ++e) ss += st[e] * st[e];
            const float sq = wave_sum(lane < 32 ? ss : 0.f), skv = wave_sum((lane >= 32 && lane < 48) ? ss : 0.f), skr = wave_sum((lane >= 48 && lane < 52) ? ss : 0.f);
            { const float rn = lane < 32 ? rsqrtf(sq * (1.0f / 256.0f) + EPS) : rsqrtf(skv * (1.0f / 128.0f) + EPS);
              if (lane < 48) *(GAS u32x4*)((bf16_t*)P + row * PROJ_LD + 8 * lane) = (u32x4){cvt_pk_bf16(st[0] * rn, st[1] * rn), cvt_pk_bf16(st[2] * rn, st[3] * rn), cvt_pk_bf16(st[4] * rn, st[5] * rn), cvt_pk_bf16(st[6] * rn, st[7] * rn)}; }
            const float rk = rsqrtf(skr * (1.0f / 32.0f) + EPS);
            const f32x4 c0 = *(const GAS f32x4*)(cosT + row * 16 + 8 * (kl & 1)), c1 = *(const GAS f32x4*)(cosT + row * 16 + 8 * (kl & 1) + 4);
            const f32x4 s0v = *(const GAS f32x4*)(sinT + row * 16 + 8 * (kl & 1)), s1v = *(const GAS f32x4*)(sinT + row * 16 + 8 * (kl & 1) + 4);
            const float sgn = (kl < 2) ? -1.0f : 1.0f;
            float ko[8];
#pragma unroll
            for (int e = 0; e < 8; ++e) { const float y = st[e] * rk * kw[e]; const float pt = __shfl_xor(y, 2);
                const float cc = e < 4 ? c0[e & 3] : c1[e & 3], sn = e < 4 ? s0v[e & 3] : s1v[e & 3]; ko[e] = y * cc + sgn * pt * sn; }
            if (lane >= 48 && lane < 52) *(GAS u32x4*)(KR + row * 32 + 8 * kl) = (u32x4){cvt_pk_bf16(ko[0], ko[1]), cvt_pk_bf16(ko[2], ko[3]), cvt_pk_bf16(ko[4], ko[5]), cvt_pk_bf16(ko[6], ko[7])};
        }
    }
}

__device__ const float INV_FREQ[16] = {1.0f, 0.5623413324356079f, 0.3162277638912201f, 0.17782793939113617f, 0.10000000149011612f, 0.05623412877321243f, 0.03162277862429619f, 0.017782794311642647f,
    0.009999999776482582f, 0.005623413249850273f, 0.003162277862429619f, 0.0017782794311642647f, 0.0010000000474974513f, 0.000562341301701963f, 0.0003162277862429619f, 0.00017782794020604342f};

__device__ __forceinline__ void sincos_reduced(float ang, float& s, float& c) {
    const double x = (double)ang;
    const double k = __builtin_rint(x * 0.15915494309189535);
    const float r = (float)(x - k * 6.283185307179586);
    s = __sinf(r); c = __cosf(r);
}

__device__ __forceinline__ void prologue(const Args& A, LAS unsigned char* lds) {
    const int tid = opq_tid(), lane = tid & 63, wid = tid >> 6;
    unsigned char* ws = opq(A.ws);
    {
        LAS float* sc = (LAS float*)lds; LAS float* red = (LAS float*)(lds + 32768);
        const float* c = (const float*)A.in[1];
        if ((int)blockIdx.x < 144) {
            for (int i = tid; i < 8192; i += 512) { const float v = ((const GAS float*)c)[i]; sc[i] = v / (1.0f + __expf(-v)); }
            __syncthreads();
        }
        for (int cgp = blockIdx.x; cgp < 144; cgp += gridDim.x)
            gemv64(sc, red, (const float*)A.in[3], MODLD, cgp * 64, MODLD, (const float*)A.in[4], (float*)(ws + WS_MOD), MODLD, tid);
    }
    __syncthreads();
    {
        const int* pos = (const int*)A.in[2]; float* cosT = (float*)(ws + WS_COS); float* sinT = (float*)(ws + WS_SIN);
        for (int idx = blockIdx.x * 512 + tid; idx < T * 16; idx += gridDim.x * 512) {
            const float ang = (float)((const GAS int*)pos)[idx >> 4] * INV_FREQ[idx & 15]; float s, c; sincos_reduced(ang, s, c); ((GAS float*)cosT)[idx] = c; ((GAS float*)sinT)[idx] = s; }
    }
    {
        LAS float* scr = (LAS float*)(lds + wid * 16384);
        const int gw = blockIdx.x * 8 + wid, NGW = gridDim.x * 8;
        const float* w13 = (const float*)A.in[6]; const float* w2 = (const float*)A.in[7]; const float* win = (const float*)A.in[8];
        const float* qan = (const float*)A.in[9]; const float* wuq = (const float*)A.in[10]; const float* kvan = (const float*)A.in[11]; const float* wukv = (const float*)A.in[12];
        const float* wbr = (const float*)A.in[18]; const float* wout = (const float*)A.in[19];
        constexpr int I13 = 16 * 176, I2 = 44 * 32, IIN = 16 * 128, IUQ = 4 * 24, IUK = 2 * 16, IV = 2 * 16, IB = 8 * 32, IO = 16 * 32;
        constexpr int NIT = 2 * I13 + 2 * I2 + IIN + IUQ + IUK + IV + 2 * IB + IO;
        for (int it = gw; it < NIT; it += NGW) {
            int r = it;
            if (r < I13) { tr_item(w13, 1024, 5632, (bf16_t*)(ws + WS_W13A), nullptr, 1, 176, scr, r, lane); continue; } r -= I13;
            if (r < I13) { tr_item(w13 + (size_t)1024 * 5632, 1024, 5632, (bf16_t*)(ws + WS_W13B), nullptr, 1, 176, scr, r, lane); continue; } r -= I13;
            if (r < I2) { tr_item(w2, 2816, 1024, (bf16_t*)(ws + WS_W2A), nullptr, 0, 32, scr, r, lane); continue; } r -= I2;
            if (r < I2) { tr_item(w2 + (size_t)2816 * 1024, 2816, 1024, (bf16_t*)(ws + WS_W2B), nullptr, 0, 32, scr, r, lane); continue; } r -= I2;
            if (r < IIN) { tr_item(win, 1024, 4000, (bf16_t*)(ws + WS_WIN), nullptr, 5, 128, scr, r, lane); continue; } r -= IIN;
            if (r < IUQ) { tr_item(wuq, 256, 768, (bf16_t*)(ws + WS_WUQ), qan, 2, 24, scr, r, lane); continue; } r -= IUQ;
            if (r < IUK) { tr_item(wukv, 128, 1024, (bf16_t*)(ws + WS_WUK), kvan, 3, 16, scr, r, lane); continue; } r -= IUK;
            if (r < IV) { tr_item(wukv, 128, 1024, (bf16_t*)(ws + WS_WV), kvan, 4, 16, scr, r, lane); continue; } r -= IV;
            if (r < IB) { tr_item(wbr, 512, 1024, (bf16_t*)(ws + WS_WB0), nullptr, 0, 32, scr, r, lane); continue; } r -= IB;
            if (r < IB) { tr_item(wbr + (size_t)512 * 1024, 512, 1024, (bf16_t*)(ws + WS_WB1), nullptr, 0, 32, scr, r, lane); continue; } r -= IB;
            tr_item(wout, 1024, 1024, (bf16_t*)(ws + WS_WOUT), nullptr, 0, 32, scr, r, lane);
        }
    }
    __syncthreads();
}

#define XB_TMO      128
#define XB_XCNT(j)  (256  + 64 * (j))
#define XB_XSUB(j)  (1280 + 64 * (j))
#define XB_XGEN(j)  (2304 + 64 * (j))
#define XB_TOP      3328
#define XB_TOPGEN   3392
#define XCD_BAR_WORDS 3456
#define XB_SPIN_CAP (1u << 22)
__device__ __forceinline__ unsigned xb_ld(unsigned* p)              { return __hip_atomic_load(p, __ATOMIC_RELAXED, __HIP_MEMORY_SCOPE_AGENT); }
__device__ __forceinline__ unsigned xb_add(unsigned* p, unsigned v) { return __hip_atomic_fetch_add(p, v, __ATOMIC_RELAXED, __HIP_MEMORY_SCOPE_AGENT); }
__device__ __forceinline__ unsigned xb_xcc_id() { return (unsigned)__builtin_amdgcn_s_getreg((3 << 11) | 20) & 0xFu; }
#define XB_SPIN(cond, bar) do { unsigned _sp = 0; while (cond) { __builtin_amdgcn_s_sleep(1); \
    if ((++_sp & 255u) == 0u) { if (xb_ld(&(bar)[XB_TMO])) break; if (_sp > XB_SPIN_CAP) { atomicAdd(&(bar)[XB_TMO], 1u); break; } } } } while (0)
struct XcdBarrier { unsigned* bar; unsigned x; volatile LAS unsigned* st; };
__device__ __forceinline__ XcdBarrier xcd_barrier_post(unsigned* bar, volatile LAS unsigned* st, int tid) {
    XcdBarrier b; b.bar = bar; b.x = xb_xcc_id(); b.st = st;
    if (tid == 0) (void)xb_add(&bar[XB_XCNT(b.x)], 1u);
    return b;
}
__device__ __forceinline__ void xcd_barrier_complete(unsigned* bar, unsigned x, unsigned& nloc, unsigned& nx) {
    const unsigned G = gridDim.x;
    unsigned sum, cnt, mine, sp = 0u;
    for (;;) {
        sum = 0u; cnt = 0u; mine = 0u;
#pragma unroll
        for (unsigned j = 0; j < 16; ++j) { const unsigned c = xb_ld(&bar[XB_XCNT(j)]); sum += c; cnt += (c > 0u) ? 1u : 0u; mine = (j == x) ? c : mine; }
        if (sum == G) break;
        __builtin_amdgcn_s_sleep(1);
        if ((++sp & 255u) == 0u) { if (xb_ld(&bar[XB_TMO])) break; if (sp > XB_SPIN_CAP) { atomicAdd(&bar[XB_TMO], 1u); break; } }
    }
    nloc = mine > 0u ? mine : 1u; nx = cnt > 0u ? cnt : 1u;
}
__device__ __forceinline__ void xcd_barrier(const XcdBarrier& b) {
    asm volatile("s_waitcnt vmcnt(0)" ::: "memory");
    __syncthreads();
    if (opq_tid() == 0) {
        unsigned* bar = b.bar;
        __builtin_amdgcn_s_waitcnt(0);
        unsigned nloc = b.st[0], nx = b.st[1];
        if (nloc == 0u) { xcd_barrier_complete(bar, b.x, nloc, nx); b.st[0] = nloc; b.st[1] = nx; }
        const unsigned old = xb_add(&bar[XB_XSUB(b.x)], 1u);
        const unsigned gen = old / nloc;
        if (old + 1u == (gen + 1u) * nloc) {
            __builtin_amdgcn_fence(__ATOMIC_RELEASE, "agent");
            asm volatile("s_waitcnt vmcnt(0)" ::: "memory");
            const unsigned og = xb_add(&bar[XB_TOP], 1u);
            const unsigned tg = og / nx;
            if (og + 1u == (tg + 1u) * nx) xb_add(&bar[XB_TOPGEN], 1u);
            else XB_SPIN(xb_ld(&bar[XB_TOPGEN]) == tg, bar);
            __builtin_amdgcn_fence(__ATOMIC_ACQUIRE, "agent");
            xb_add(&bar[XB_XGEN(b.x)], 1u);
            asm volatile("s_waitcnt vmcnt(0)" ::: "memory");
        } else {
            XB_SPIN(xb_ld(&bar[XB_XGEN(b.x)]) == gen, bar);
            __builtin_amdgcn_fence(__ATOMIC_ACQUIRE, "agent");
            asm volatile("s_waitcnt vmcnt(0)" ::: "memory");
        }
    }
    __syncthreads();
}

#ifndef MK_PER_PHASE
#define MK_PER_PHASE 0
#endif
__global__ void __launch_bounds__(512) fwd_kernel(Args A) {
    extern __shared__ __attribute__((aligned(16))) unsigned char lds_raw[];
    LAS unsigned char* lds = (LAS unsigned char*)lds_raw;
    cg::grid_group grid = cg::this_grid();
    const int G = gridDim.x, cidx = blockIdx.x;
    { const int t0 = opq_tid(); if (t0 < 32) ((LAS unsigned*)(lds + LDS_MISC))[t0] = 0u; __syncthreads(); }
    (void)xcd_barrier_post((unsigned*)(A.ws + WS_BAR), (volatile LAS unsigned*)(lds + LDS_MISC), opq_tid());
    const int lo = A.ph_lo, hi = A.ph_hi; (void)lo; (void)hi;
#if MK_PER_PHASE
#define IN(k) (lo <= (k) && (k) < hi)
#define SEAM(k) do { } while (0)
#else
#define IN(k) true
#define SEAM(k) do { if ((k) == 0) grid.sync(); else { XcdBarrier xb_; xb_.bar = (unsigned*)(opq(A.ws) + WS_BAR); xb_.x = xb_xcc_id(); xb_.st = (volatile LAS unsigned*)(lds + LDS_MISC); xcd_barrier(xb_); } } while (0)
#endif
#define WSP(T_, off) ((T_*)(ws + (off)))
#ifndef DUP
#define DUP 0
#endif
#if DUP
#define REP(k) for (int rep_ = 0; rep_ <= ((DUP >> (k)) & 1); ++rep_)
#else
#define REP(k)
#endif
    using namespace pg8;

    REP(0) { if (IN(0)) { prologue(A, lds); } SEAM(0); }
    REP(1) { if (IN(1)) { xa_phase(A, lds); } SEAM(1); }
    REP(2) { if (IN(2)) { unsigned char* ws = opq(A.ws); Gemm g{WSP(const bf16_t, WS_H), WSP(const bf16_t, WS_W13A), T, 2 * FF, DM, DM, DM}; StaticOrder S; S.init(T, 2 * FF, G, cidx);
        EpiSwiGLU E{WSP(bf16_t, WS_BIG), WSP(const float, WS_SSP), WSP(const float, WS_SHW0)}; gemm_phase<EpiSwiGLU, StaticOrder, true>(lds, g, S, E); } SEAM(2); }
    REP(3) { if (IN(3)) { unsigned char* ws = opq(A.ws); Gemm g{WSP(const bf16_t, WS_BIG), WSP(const bf16_t, WS_W2A), T, DM, FF, FF, FF}; StaticOrder S; S.init(T, DM, G, cidx);
        EpiResidN<0> E{opq((const float*)A.in[0]), opq(A.out), WSP(bf16_t, WS_H), WSP(float, WS_SSP), WSP(const float, WS_MOD) + 0 * 3072 + 2048, WSP(const float, WS_AVEC), 0.5f};
        gemm_phase<EpiResidN<0>, StaticOrder, true>(lds, g, S, E); } SEAM(3); }
    REP(5) { if (IN(5)) { unsigned char* ws = opq(A.ws); Gemm g{WSP(const bf16_t, WS_H), WSP(const bf16_t, WS_WIN), T, PROJ_LD, DM, DM, DM}; StaticOrder S; S.init(T, PROJ_LD, G, cidx);
        EpiProj E{WSP(bf16_t, WS_BIG), WSP(const float, WS_SSP), WSP(const float, WS_SHW1)}; gemm_phase<EpiProj, StaticOrder, true>(lds, g, S, E); } SEAM(5); }
    REP(6) { if (IN(6)) { unsigned char* ws = opq(A.ws); conv_phase(WSP(const bf16_t, WS_BIG), (const float*)A.in[17], (const float*)A.in[16], WSP(const float, WS_COS), WSP(const float, WS_SIN),
        WSP(float, WS_RSTDQ), WSP(float, WS_RSTDKV), WSP(bf16_t, WS_KR), WSP(bf16_t, WS_OCONV)); } SEAM(6); }
    REP(7) { if (IN(7)) {
        { unsigned char* ws = opq(A.ws); Gemm g{WSP(const bf16_t, WS_BIG), WSP(const bf16_t, WS_WUQ), T, 768, 256, PROJ_LD, 256}; StaticOrder S; S.init(T, 768, G, cidx);
          EpiQK<2> E{WSP(bf16_t, WS_Q), QLD, 96, WSP(const float, WS_RSTDQ), (const float*)A.in[13], (const float*)A.in[15], WSP(const float, WS_COS), WSP(const float, WS_SIN), QSCALE};
          gemm_phase<EpiQK<2>, StaticOrder, true>(lds, g, S, E); }
        { unsigned char* ws = opq(A.ws); Gemm g{WSP(const bf16_t, WS_BIG) + 256, WSP(const bf16_t, WS_WUK), T, 512, 128, PROJ_LD, 128}; StaticOrder S; S.init(T, 512, G, cidx);
          EpiQK<-1> E{WSP(bf16_t, WS_KN), 512, 64, WSP(const float, WS_RSTDKV), (const float*)A.in[14], nullptr, nullptr, nullptr, 1.0f};
          gemm_phase<EpiQK<-1>, StaticOrder, true>(lds, g, S, E); }
        { unsigned char* ws = opq(A.ws); Gemm g{WSP(const bf16_t, WS_WV), WSP(const bf16_t, WS_BIG) + 256, 512, T, 128, 128, PROJ_LD}; StaticOrder S; S.init(512, T, G, cidx);
          EpiVT E{WSP(bf16_t, WS_VT), WSP(const float, WS_RSTDKV)}; gemm_phase<EpiVT, StaticOrder, true>(lds, g, S, E); }
    } SEAM(7); }
    REP(8) { if (IN(8)) { unsigned char* ws = opq(A.ws); att::phase(lds, WSP(const bf16_t, WS_Q), WSP(const bf16_t, WS_KN), WSP(const bf16_t, WS_KR), WSP(const bf16_t, WS_VT), WSP(bf16_t, WS_OATT)); } SEAM(8); }
    REP(9) { if (IN(9)) {
        { unsigned char* ws = opq(A.ws); Gemm g{WSP(const bf16_t, WS_OATT), WSP(const bf16_t, WS_WB0), T, DM, 512, 512, 512}; StaticOrder S; S.init(T, DM, G, cidx);
          EpiBranch<true> E{WSP(bf16_t, WS_MERGED), WSP(const bf16_t, WS_BIG) + C_GL}; gemm_phase<EpiBranch<true>, StaticOrder, true>(lds, g, S, E); }
        { unsigned char* ws = opq(A.ws); Gemm g{WSP(const bf16_t, WS_OCONV), WSP(const bf16_t, WS_WB1), T, DM, 512, 512, 512}; StaticOrder S; S.init(T, DM, G, cidx);
          EpiBranch<false> E{WSP(bf16_t, WS_MERGED), WSP(const bf16_t, WS_BIG) + C_GL + 1024}; gemm_phase<EpiBranch<false>, StaticOrder, true>(lds, g, S, E); }
    } SEAM(9); }
    REP(10) { if (IN(10)) { unsigned char* ws = opq(A.ws); Gemm g{WSP(const bf16_t, WS_MERGED), WSP(const bf16_t, WS_WOUT), T, DM, DM, DM, DM}; StaticOrder S; S.init(T, DM, G, cidx);
        EpiResidN<1> E{opq(A.out), WSP(bf16_t, WS_X2B), WSP(bf16_t, WS_H), WSP(float, WS_SSP), WSP(const float, WS_MOD) + 1 * 3072 + 2048, WSP(const float, WS_AVEC) + 8 * 1024, 1.0f};
        gemm_phase<EpiResidN<1>, StaticOrder, true>(lds, g, S, E); } SEAM(10); }
    REP(12) { if (IN(12)) { unsigned char* ws = opq(A.ws); Gemm g{WSP(const bf16_t, WS_H), WSP(const bf16_t, WS_W13B), T, 2 * FF, DM, DM, DM}; StaticOrder S; S.init(T, 2 * FF, G, cidx);
        EpiSwiGLU E{WSP(bf16_t, WS_BIG), WSP(const float, WS_SSP), WSP(const float, WS_SHW2)}; gemm_phase<EpiSwiGLU, StaticOrder, true>(lds, g, S, E); } SEAM(12); }
    if (IN(13)) { unsigned char* ws = opq(A.ws); Gemm g{WSP(const bf16_t, WS_BIG), WSP(const bf16_t, WS_W2B), T, DM, FF, FF, FF}; StaticOrder S; S.init(T, DM, G, cidx);
        EpiResidN<2> E{WSP(const bf16_t, WS_X2B), opq(A.out), nullptr, nullptr, WSP(const float, WS_MOD) + 2 * 3072 + 2048, nullptr, 0.5f};
        gemm_phase<EpiResidN<2>, StaticOrder, true>(lds, g, S, E); }
#undef IN
#undef SEAM
#undef WSP
#undef REP
}

extern "C" void kernel_launch(void* const* d_in, const int* in_sizes, int n_in, void* d_out, int out_size, void* d_ws, size_t ws_size, hipStream_t stream) {
    static int grid = 0;
    if (grid == 0) {
        if (n_in != 20 || out_size != T * DM || ws_size < WS_END) { fprintf(stderr, "kernel_launch: unexpected shapes (n_in %d out %d ws %zu)\n", n_in, out_size, ws_size); grid = -1; return; }
        int dev = 0, cus = 0, per_cu = 0;
        hipGetDevice(&dev); hipDeviceGetAttribute(&cus, hipDeviceAttributeMultiprocessorCount, dev);
        if (hipFuncSetAttribute((const void*)fwd_kernel, hipFuncAttributeMaxDynamicSharedMemorySize, LDS_BYTES) != hipSuccess) { fprintf(stderr, "kernel_launch: hipFuncSetAttribute failed\n"); grid = -1; return; }
        if (hipOccupancyMaxActiveBlocksPerMultiprocessor(&per_cu, (const void*)fwd_kernel, 512, LDS_BYTES) != hipSuccess || per_cu < 1) per_cu = 1;
        (void)hipGetLastError();
        grid = cus * per_cu;
        if (grid > 256) grid = 256;
    }
    if (grid < 0) return;
    if (hipMemsetAsync((char*)d_ws + WS_BAR, 0, BAR_BYTES, stream) != hipSuccess) { fprintf(stderr, "kernel_launch: memset failed\n"); return; }
    Args a{};
    for (int i = 0; i < 20; ++i) a.in[i] = d_in[i];
    a.out = (float*)d_out; a.ws = (unsigned char*)d_ws;
#if MK_PER_PHASE
    for (int p = 0; p < 14; ++p) { a.ph_lo = p; a.ph_hi = p + 1; hipLaunchKernelGGL(fwd_kernel, dim3(grid), dim3(512), LDS_BYTES, stream, a); }
#else
    a.ph_lo = 0; a.ph_hi = 14;
    void* args[] = {&a};
    hipError_t e = hipLaunchCooperativeKernel((const void*)fwd_kernel, dim3(grid), dim3(512), args, LDS_BYTES, stream);
    if (e != hipSuccess) fprintf(stderr, "cooperative launch failed: %s (grid %d)\n", hipGetErrorString(e), grid);
#endif
}
```

```cpp
#include <hip/hip_runtime.h>
#include <hip/hip_cooperative_groups.h>
#include <cstdio>
#include <cstdint>
namespace cg = cooperative_groups;

#define LAS __attribute__((address_space(3)))
#define GAS __attribute__((address_space(1)))
typedef unsigned short bf16_t;
typedef short bf16x8 __attribute__((ext_vector_type(8)));
typedef float f32x4 __attribute__((ext_vector_type(4)));
typedef float f32x16 __attribute__((ext_vector_type(16)));
typedef unsigned u32x4 __attribute__((ext_vector_type(4)));
typedef unsigned u32x2 __attribute__((ext_vector_type(2)));

constexpr int BATCH = 8, SEQ = 8192, T = BATCH * SEQ, DM = 1024, FF = 2816, NH = 8;
constexpr int QLD = 768, PROJ_LD = 4096, MODLD = 9216;
constexpr int C_CONV = 416, C_GB = 928, C_GC = 1440, C_GL = 1952;
constexpr float EPS = 1e-6f;
constexpr float QSCALE = 0.10206207261596577f * 1.4426950408889634f;

constexpr size_t MiB = 1u << 20;
constexpr size_t WS_MOD = 0, WS_RSTDQ = 1 * MiB, WS_RSTDKV = 1 * MiB + 512 * 1024, WS_COS = 2 * MiB, WS_SIN = 6 * MiB, WS_KR = 10 * MiB;
constexpr size_t WS_W13A = 16 * MiB, WS_W13B = 27 * MiB, WS_W2A = 38 * MiB, WS_W2B = 38 * MiB + 5632 * 1024, WS_WIN = 49 * MiB;
constexpr size_t WS_WUQ = 57 * MiB, WS_WUK = 57 * MiB + 512 * 1024, WS_WV = 57 * MiB + 768 * 1024, WS_WB0 = 58 * MiB, WS_WB1 = 59 * MiB, WS_WOUT = 60 * MiB;
constexpr size_t WS_H = 64 * MiB, WS_OATT = 64 * MiB, WS_OCONV = 128 * MiB;
constexpr size_t WS_BIG = 192 * MiB;
constexpr size_t WS_Q = 704 * MiB, WS_KN = 800 * MiB, WS_MERGED = 704 * MiB, WS_VT = 864 * MiB, WS_SSP = 928 * MiB, WS_END = 932 * MiB;
constexpr size_t WS_SHW0 = 14 * MiB, WS_SHW1 = 14 * MiB + 256 * 1024, WS_SHW2 = 14 * MiB + 512 * 1024, WS_AVEC = 14 * MiB + 768 * 1024;
constexpr size_t WS_X2B = 544 * MiB;

constexpr size_t WS_BAR = 15 * MiB, BAR_BYTES = 16384;
constexpr int LDS_BYTES = 147456, LDS_MISC = 131072 + 320;

template <class P> __device__ __forceinline__ P* opq(P* p) { asm volatile("" : "+s"(p)); return p; }
__device__ __forceinline__ int opq_tid() { int t = threadIdx.x; asm volatile("" : "+v"(t)); return t; }
__device__ __forceinline__ unsigned cvt_pk_bf16(float lo, float hi) { unsigned r; asm("v_cvt_pk_bf16_f32 %0, %1, %2" : "=v"(r) : "v"(lo), "v"(hi)); return r; }
__device__ __forceinline__ float bf_lo(unsigned w) { return __uint_as_float(w << 16); }
__device__ __forceinline__ float bf_hi(unsigned w) { return __uint_as_float(w & 0xffff0000u); }
__device__ __forceinline__ float fast_sigmoid(float x) { return __builtin_amdgcn_rcpf(1.0f + __expf(-x)); }
__device__ __forceinline__ u32x4 pack8(f32x4 a, f32x4 b) { u32x4 w; w.x = cvt_pk_bf16(a[0], a[1]); w.y = cvt_pk_bf16(a[2], a[3]); w.z = cvt_pk_bf16(b[0], b[1]); w.w = cvt_pk_bf16(b[2], b[3]); return w; }
__device__ __forceinline__ float wave_sum(float v) {
#pragma unroll
    for (int o = 1; o < 64; o <<= 1) v += __shfl_xor(v, o);
    return v;
}

namespace pg8 {
constexpr int BM = 256, BK = 64, HALF = 128, HTB = HALF * BK * 2, STAGE_BYTES = 8 * HTB, NXCD = 8, WGM = 8;
__host__ __device__ __forceinline__ int lds_byte(int r, int c) { const int st = (r >> 4) * 2 + (c >> 5), rr = r & 15, cc = c & 31, ob = rr * 64 + cc * 2; return st * 1024 + (ob ^ (((ob >> 9) & 1) << 5)); }
__host__ __device__ __forceinline__ void stage_rc(int b, int& R, int& C) { const int st = b / 1024, sb = b % 1024, swz = sb ^ (((sb >> 9) & 1) << 5); R = (st >> 1) * 16 + swz / 64; C = (st & 1) * 32 + (swz % 64) / 2; }
__host__ __device__ __forceinline__ int perm32(int rho) { const int n = rho >> 4, i = rho & 15; return 8 * (i >> 2) + 4 * n + (i & 3); }

struct Unit { int pm, pn; };
struct Gemm { const bf16_t* A; const bf16_t* Bt; int M, N, K, lda, ldb; };

struct StaticOrder {
    int nM, nN, nwg, G, c;
    __host__ __device__ void init(int M, int N, int G_, int c_) { nM = M / BM; nN = N / BM; nwg = nM * nN; G = G_; c = c_; }
    __host__ __device__ bool next(int i, Unit& u) const {
        const long L = (long)i * G + c; if (L >= nwg) return false;
        int wgid = (int)L; { const int q = nwg / NXCD, r = nwg % NXCD, xcd = wgid % NXCD, off = wgid / NXCD; wgid = (xcd < r ? xcd * (q + 1) : r * (q + 1) + (xcd - r) * q) + off; }
        const int nig = WGM * nN, gid = wgid / nig, fm = gid * WGM, gsz = (nM - fm) < WGM ? (nM - fm) : WGM;
        u.pm = fm + ((wgid % nig) % gsz); u.pn = (wgid % nig) / gsz; return true;
    }
};

template <class Epi, class Sched, bool ALIGN_EPI>
__device__ __forceinline__ void gemm_phase(LAS unsigned char* lds, const Gemm g, const Sched& S, const Epi& E) {
    int tid_ = threadIdx.x; asm volatile("" : "+v"(tid_));
    const int tid = tid_, wid = __builtin_amdgcn_readfirstlane(tid >> 6), lane = tid & 63, wr = wid >> 2, wc = wid & 3, fr = lane & 15, fq = lane >> 4;
    const int K = g.K, nt = K / BK;
    unsigned voffA[2], voffB[2];
#pragma unroll
    for (int i = 0; i < 2; ++i) { int R, C; stage_rc(tid * 16 + i * 8192, R, C); const int Rb = Epi::PERM ? ((R & ~31) + perm32(R & 31)) : R;
        voffA[i] = (unsigned)(R * g.lda + C) * 2u; voffB[i] = (unsigned)(Rb * g.ldb + C) * 2u; }
    const size_t kstep = (size_t)(BK * 2);
    const size_t hstepA = (size_t)HALF * g.lda * 2, hstepB = (size_t)HALF * g.ldb * 2;
    const size_t tstepA = 2 * hstepA, tstepB = 2 * hstepB;
    const unsigned ldsw = (unsigned)wid * 1024u;
    const int aoff = lds_byte(wr * 64 + fr, fq * 8), boff = lds_byte(wc * 32 + fr, fq * 8);
#define PG8_SA(b, h) (((b) * 2 + (h)) * HTB)
#define PG8_SB(b, h) ((4 + (b) * 2 + (h)) * HTB)
#define PG8_STAGE(bufoff, gbase, voff) do { _Pragma("unroll") for (int _i = 0; _i < 2; ++_i) \
        __builtin_amdgcn_global_load_lds((const unsigned*)((const char*)(gbase) + (voff)[_i]), (LAS unsigned*)(lds + (bufoff) + ldsw + _i * 8192), 16, 0, 0); } while (0)
#define PG8_LDA(dst, b, h) do { _Pragma("unroll") for (int m = 0; m < 4; ++m) _Pragma("unroll") for (int k = 0; k < 2; ++k) dst[m][k] = *(const LAS bf16x8*)(lds + PG8_SA(b, h) + aoff + m * 2048 + k * 1024); } while (0)
#define PG8_LDB(dst, b, h) do { _Pragma("unroll") for (int n = 0; n < 2; ++n) _Pragma("unroll") for (int k = 0; k < 2; ++k) dst[n][k] = *(const LAS bf16x8*)(lds + PG8_SB(b, h) + boff + n * 2048 + k * 1024); } while (0)
#define PG8_MMA(ai, bj, At, Bt) do { __builtin_amdgcn_s_setprio(1); _Pragma("unroll") for (int m = 0; m < 4; ++m) _Pragma("unroll") for (int n = 0; n < 2; ++n) _Pragma("unroll") for (int k = 0; k < 2; ++k) \
        acc[ai][bj][m][n] = __builtin_amdgcn_mfma_f32_16x16x32_bf16(Bt[n][k], At[m][k], acc[ai][bj][m][n], 0, 0, 0); __builtin_amdgcn_s_setprio(0); } while (0)
#define PG8_WAIT_V(n) asm volatile("s_waitcnt vmcnt(" #n ")" ::: "memory")
#define PG8_WAIT_L(n) asm volatile("s_waitcnt lgkmcnt(" #n ")" ::: "memory")
#define PG8_BAR __builtin_amdgcn_s_barrier()
#define PG8_SCHED __builtin_amdgcn_sched_barrier(0)
    Unit cur, nxt; int ui = 0;
    if (!S.next(0, cur)) return;
    f32x4 acc[2][2][4][2];
#pragma unroll
    for (int a = 0; a < 2; ++a)
#pragma unroll
        for (int b = 0; b < 2; ++b)
#pragma unroll
            for (int m = 0; m < 4; ++m)
#pragma unroll
                for (int n = 0; n < 2; ++n) acc[a][b][m][n] = (f32x4){0.f, 0.f, 0.f, 0.f};
    bf16x8 At[4][2], B0[2][2], B1[2][2];
    const char* cA = (const char*)g.A + (size_t)cur.pm * tstepA; const char* cB = (const char*)g.Bt + (size_t)cur.pn * tstepB;
    PG8_STAGE(PG8_SB(0, 0), cB, voffB); PG8_STAGE(PG8_SB(0, 1), cB + hstepB, voffB); PG8_STAGE(PG8_SA(0, 0), cA, voffA); PG8_STAGE(PG8_SA(0, 1), cA + hstepA, voffA);
    if (wr == 1) PG8_BAR;
    PG8_WAIT_V(2); PG8_BAR;
    PG8_STAGE(PG8_SB(1, 0), cB + kstep, voffB); PG8_STAGE(PG8_SA(1, 0), cA + kstep, voffA); PG8_STAGE(PG8_SB(1, 1), cB + hstepB + kstep, voffB);
    PG8_WAIT_V(6); PG8_BAR;
    for (;;) {
        const bool has_next = S.next(ui + 1, nxt);
        const char* nA = has_next ? (const char*)g.A + (size_t)nxt.pm * tstepA : cA; const char* nB = has_next ? (const char*)g.Bt + (size_t)nxt.pn * tstepB : cB;
        for (int t = 0; t < nt; t += 2) {
            const bool last = (t == nt - 2);
            const char* a1 = cA + (size_t)(t + 1) * kstep;
            const char* a2 = last ? nA : cA + (size_t)(t + 2) * kstep; const char* b2 = last ? nB : cB + (size_t)(t + 2) * kstep;
            const char* a3 = a2 + kstep; const char* b3 = b2 + kstep;
            PG8_LDB(B0, 0, 0); PG8_LDB(B1, 0, 1); PG8_SCHED; PG8_LDA(At, 0, 0); PG8_STAGE(PG8_SA(1, 1), a1 + hstepA, voffA);
            PG8_WAIT_V(8); PG8_WAIT_L(0); PG8_BAR; PG8_MMA(0, 0, At, B0); PG8_MMA(0, 1, At, B1); PG8_BAR; PG8_SCHED;
            PG8_LDA(At, 0, 1); PG8_STAGE(PG8_SB(0, 0), b2, voffB); PG8_STAGE(PG8_SB(0, 1), b2 + hstepB, voffB); PG8_STAGE(PG8_SA(0, 0), a2, voffA);
            PG8_WAIT_V(8); PG8_WAIT_L(0); PG8_BAR; PG8_MMA(1, 0, At, B0); PG8_MMA(1, 1, At, B1); PG8_BAR; PG8_SCHED;
            PG8_LDB(B0, 1, 0); PG8_LDB(B1, 1, 1); PG8_SCHED; PG8_LDA(At, 1, 0); PG8_STAGE(PG8_SA(0, 1), a2 + hstepA, voffA);
            PG8_WAIT_V(8); PG8_WAIT_L(0); PG8_BAR; PG8_MMA(0, 0, At, B0); PG8_MMA(0, 1, At, B1); PG8_BAR; PG8_SCHED;
            PG8_LDA(At, 1, 1); PG8_STAGE(PG8_SB(1, 0), b3, voffB); PG8_STAGE(PG8_SB(1, 1), b3 + hstepB, voffB); PG8_STAGE(PG8_SA(1, 0), a3, voffA);
            PG8_WAIT_V(8); PG8_WAIT_L(0); PG8_BAR; PG8_MMA(1, 0, At, B0); PG8_MMA(1, 1, At, B1); PG8_BAR; PG8_SCHED;
        }
        if constexpr (ALIGN_EPI) { if (wr == 0) PG8_BAR; }
        { int fr_ = fr, fq_ = fq; asm volatile("" : "+v"(fr_), "+v"(fq_)); E(acc, cur, wr, wc, fr_, fq_); }
        if (!has_next) break;
#pragma unroll
        for (int a = 0; a < 2; ++a)
#pragma unroll
            for (int b = 0; b < 2; ++b)
#pragma unroll
                for (int m = 0; m < 4; ++m)
#pragma unroll
                    for (int n = 0; n < 2; ++n) acc[a][b][m][n] = (f32x4){0.f, 0.f, 0.f, 0.f};
        cur = nxt; cA = nA; cB = nB; ++ui;
        if constexpr (ALIGN_EPI) { if (wr == 1) PG8_BAR; }
    }
    PG8_WAIT_V(0);
    if constexpr (!ALIGN_EPI) { if (wr == 0) PG8_BAR; }
    PG8_BAR;
#undef PG8_SA
#undef PG8_SB
#undef PG8_STAGE
#undef PG8_LDA
#undef PG8_LDB
#undef PG8_MMA
#undef PG8_WAIT_V
#undef PG8_WAIT_L
#undef PG8_BAR
#undef PG8_SCHED
}

typedef f32x4 Acc[2][2][4][2];

struct EpiStoreBf16 { static constexpr bool PERM = true; bf16_t* O; int ldc;
    __device__ __forceinline__ void operator()(const Acc& acc, const Unit& u, int wr, int wc, int fr, int fq) const {
        const int row0 = u.pm * BM + wr * 64 + fr, col0 = u.pn * BM + wc * 32 + 8 * fq;
#pragma unroll
        for (int ai = 0; ai < 2; ++ai)
#pragma unroll
            for (int m = 0; m < 4; ++m) { bf16_t* rowp = O + (size_t)(row0 + ai * HALF + m * 16) * ldc + col0;
#pragma unroll
                for (int bj = 0; bj < 2; ++bj) *(GAS u32x4*)(rowp + bj * HALF) = pack8(acc[ai][bj][m][0], acc[ai][bj][m][1]); }
    }
};
__device__ __forceinline__ void rstd8_from_ssp(const float* ssp, int row0, int fq, float (&rs)[2][4]) {
    f32x4 p[2][4];
#pragma unroll
    for (int ai = 0; ai < 2; ++ai)
#pragma unroll
        for (int m = 0; m < 4; ++m) p[ai][m] = *(const GAS f32x4*)(ssp + (size_t)(row0 + ai * 128 + m * 16) * 16 + 4 * fq);
#pragma unroll
    for (int ai = 0; ai < 2; ++ai)
#pragma unroll
        for (int m = 0; m < 4; ++m) { float v = (p[ai][m][0] + p[ai][m][1]) + (p[ai][m][2] + p[ai][m][3]); v += __shfl_xor(v, 16); v += __shfl_xor(v, 32); rs[ai][m] = rsqrtf(v * (1.0f / DM) + EPS); }
}
struct EpiSwiGLU { static constexpr bool PERM = true; bf16_t* O; const float* ssp; const float* shw;
    __device__ __forceinline__ void operator()(const Acc& acc, const Unit& u, int wr, int wc, int fr, int fq) const {
        const int row0 = u.pm * BM + wr * 64 + fr, col0 = u.pn * HALF + wc * 32 + 8 * fq, b = u.pm >> 5;
        f32x4 sg[2], su[2];
#pragma unroll
        for (int n = 0; n < 2; ++n) { sg[n] = *(const GAS f32x4*)(shw + (size_t)b * (2 * FF) + col0 + 4 * n); su[n] = *(const GAS f32x4*)(shw + (size_t)b * (2 * FF) + FF + col0 + 4 * n); }
        float rs8[2][4]; rstd8_from_ssp(ssp, row0, fq, rs8);
#pragma unroll
        for (int ai = 0; ai < 2; ++ai)
#pragma unroll
            for (int m = 0; m < 4; ++m) { const int row = row0 + ai * HALF + m * 16; const float rs = rs8[ai][m];
                bf16_t* rowp = O + (size_t)row * FF + col0;
                f32x4 o[2];
#pragma unroll
                for (int n = 0; n < 2; ++n)
#pragma unroll
                    for (int e = 0; e < 4; ++e) { const float gg = acc[ai][0][m][n][e] * rs + sg[n][e], uu = acc[ai][1][m][n][e] * rs + su[n][e]; o[n][e] = gg * fast_sigmoid(gg) * uu; }
                *(GAS u32x4*)rowp = pack8(o[0], o[1]);
                asm volatile("" ::: "memory"); }
    }
};
struct EpiProj { static constexpr bool PERM = true; bf16_t* O; const float* ssp; const float* shw;
    __device__ __forceinline__ void operator()(const Acc& acc, const Unit& u, int wr, int wc, int fr, int fq) const {
        const int row0 = u.pm * BM + wr * 64 + fr, col0 = u.pn * BM + wc * 32 + 8 * fq, b = u.pm >> 5;
        float rs8[2][4]; rstd8_from_ssp(ssp, row0, fq, rs8);
#pragma unroll
        for (int ai = 0; ai < 2; ++ai)
#pragma unroll
            for (int m = 0; m < 4; ++m) { const int row = row0 + ai * HALF + m * 16; const float rs = rs8[ai][m];
                bf16_t* rowp = O + (size_t)row * PROJ_LD + col0;
#pragma unroll
                for (int bj = 0; bj < 2; ++bj) { const f32x4 h0 = *(const GAS f32x4*)(shw + (size_t)b * PROJ_LD + col0 + bj * HALF), h1 = *(const GAS f32x4*)(shw + (size_t)b * PROJ_LD + col0 + bj * HALF + 4);
                    *(GAS u32x4*)(rowp + bj * HALF) = pack8(acc[ai][bj][m][0] * rs + h0, acc[ai][bj][m][1] * rs + h1); }
                asm volatile("" ::: "memory"); }
    }
};
template <int MODE> struct EpiResidN { static constexpr bool PERM = true; const void* base; void* xout; bf16_t* xa; float* ssp; const float* gate; const float* avec; float s;
    __device__ __forceinline__ void operator()(const Acc& acc, const Unit& u, int wr, int wc, int fr, int fq) const {
        const int row0 = u.pm * BM + wr * 64 + fr, col0 = u.pn * BM + wc * 32 + 8 * fq, b = u.pm >> 5;
        float ss[2][4];
#pragma unroll
        for (int ai = 0; ai < 2; ++ai)
#pragma unroll
            for (int m = 0; m < 4; ++m) ss[ai][m] = 0.f;
#pragma unroll
        for (int bj = 0; bj < 2; ++bj) { const int c = col0 + bj * HALF;
            const f32x4 g0 = *(const GAS f32x4*)(gate + (size_t)b * MODLD + c) * s, g1 = *(const GAS f32x4*)(gate + (size_t)b * MODLD + c + 4) * s;
            f32x4 a0 = {0.f, 0.f, 0.f, 0.f}, a1 = {0.f, 0.f, 0.f, 0.f};
            if (MODE < 2) { a0 = *(const GAS f32x4*)(avec + (size_t)b * DM + c); a1 = *(const GAS f32x4*)(avec + (size_t)b * DM + c + 4); }
            constexpr int NB = MODE == 0 ? 2 : 4;
#pragma unroll
            for (int r0 = 0; r0 < 8; r0 += NB) {
                f32x4 bf[NB][2]; u32x4 bw[NB];
#pragma unroll
                for (int q = 0; q < NB; ++q) { const int ai = (r0 + q) >> 2, m = (r0 + q) & 3; const size_t off = (size_t)(row0 + ai * HALF + m * 16) * DM + c;
                    if (MODE == 0) { bf[q][0] = *(const GAS f32x4*)((const float*)base + off); bf[q][1] = *(const GAS f32x4*)((const float*)base + off + 4); }
                    else bw[q] = *(const GAS u32x4*)((const bf16_t*)base + off); }
#pragma unroll
                for (int q = 0; q < NB; ++q) { const int ai = (r0 + q) >> 2, m = (r0 + q) & 3; const size_t off = (size_t)(row0 + ai * HALF + m * 16) * DM + c;
                    f32x4 b0, b1;
                    if (MODE == 0) { b0 = bf[q][0]; b1 = bf[q][1]; }
                    else { const u32x4 w = bw[q]; b0 = (f32x4){bf_lo(w.x), bf_hi(w.x), bf_lo(w.y), bf_hi(w.y)}; b1 = (f32x4){bf_lo(w.z), bf_hi(w.z), bf_lo(w.w), bf_hi(w.w)}; }
                    const f32x4 o0 = b0 + g0 * acc[ai][bj][m][0], o1 = b1 + g1 * acc[ai][bj][m][1];
                    if (MODE == 2) { *(GAS f32x4*)((float*)xout + off) = o0; *(GAS f32x4*)((float*)xout + off + 4) = o1; }
                    else { *(GAS u32x4*)((bf16_t*)xout + off) = pack8(o0, o1); *(GAS u32x4*)(xa + off) = pack8(o0 * a0, o1 * a1);
                        const f32x4 q0 = o0 * o0, q1 = o1 * o1; ss[ai][m] += ((q0[0] + q0[1]) + (q0[2] + q0[3])) + ((q1[0] + q1[1]) + (q1[2] + q1[3])); } }
                asm volatile("" ::: "memory");
            }
        }
        if (MODE < 2) {
#pragma unroll
            for (int ai = 0; ai < 2; ++ai)
#pragma unroll
                for (int m = 0; m < 4; ++m) { float v = ss[ai][m]; v += __shfl_xor(v, 16); v += __shfl_xor(v, 32);
                    if (fq == 0) ((GAS float*)ssp)[(size_t)(row0 + ai * HALF + m * 16) * 16 + u.pn * 4 + wc] = v; }
        }
    }
};
struct EpiVT { static constexpr bool PERM = true; bf16_t* O; const float* rstd;
    __device__ __forceinline__ void operator()(const Acc& acc, const Unit& u, int wr, int wc, int fr, int fq) const {
        const int row0 = u.pm * BM + wr * 64 + fr, col0 = u.pn * BM + wc * 32 + 8 * fq;
#pragma unroll
        for (int ai = 0; ai < 2; ++ai)
#pragma unroll
            for (int m = 0; m < 4; ++m) { bf16_t* rowp = O + (size_t)(row0 + ai * HALF + m * 16) * T + col0;
#pragma unroll
                for (int bj = 0; bj < 2; ++bj) *(GAS u32x4*)(rowp + bj * HALF) = pack8(acc[ai][bj][m][0], acc[ai][bj][m][1]); }
    }
};
template <int ROPE_TILE> struct EpiQK { static constexpr bool PERM = true; bf16_t* O; int ldo, hw; const float* rstd; const float* wn; const float* wrp; const float* cosT; const float* sinT; float c2;
    __device__ __forceinline__ void operator()(const Acc& acc, const Unit& u, int wr, int wc, int fr, int fq) const {
        const int row0 = u.pm * BM + wr * 64 + fr;
        const float* wn = this->wn; const float* wrp = this->wrp;
        asm volatile("" : "+s"(wn), "+s"(wrp));
        if (ROPE_TILE < 0 || u.pn != ROPE_TILE) {
            const int head = 4 * u.pn + wc;
#pragma unroll
            for (int ai = 0; ai < 2; ++ai)
#pragma unroll
                for (int m = 0; m < 4; ++m) { const int row = row0 + ai * HALF + m * 16; const float rs = 1.0f;
                    float ss = 0.f;
#pragma unroll
                    for (int bj = 0; bj < 2; ++bj)
#pragma unroll
                        for (int n = 0; n < 2; ++n) { const f32x4 q = acc[ai][bj][m][n] * acc[ai][bj][m][n]; ss += (q[0] + q[1]) + (q[2] + q[3]); }
                    ss += __shfl_xor(ss, 16); ss += __shfl_xor(ss, 32);
                    const float f = rs * rsqrtf(ss * rs * rs * (1.0f / 64.0f) + EPS) * c2;
                    bf16_t* rowp = O + (size_t)row * ldo + head * hw + 8 * fq;
#pragma unroll
                    for (int bj = 0; bj < 2; ++bj) { const f32x4 w0 = *(const GAS f32x4*)(wn + 32 * bj + 8 * fq), w1 = *(const GAS f32x4*)(wn + 32 * bj + 8 * fq + 4);
                        *(GAS u32x4*)(rowp + 32 * bj) = pack8(acc[ai][bj][m][0] * f * w0, acc[ai][bj][m][1] * f * w1); }
                    asm volatile("" ::: "memory"); }
        } else {
            const float sgn = (fq < 2) ? -1.0f : 1.0f;
#pragma unroll
            for (int ai = 0; ai < 2; ++ai)
#pragma unroll
                for (int m = 0; m < 4; ++m) { const int row = row0 + ai * HALF + m * 16; const float rs = 1.0f;
#pragma unroll
                    for (int bj = 0; bj < 2; ++bj) { float ss = 0.f;
#pragma unroll
                        for (int n = 0; n < 2; ++n) { const f32x4 q = acc[ai][bj][m][n] * acc[ai][bj][m][n]; ss += (q[0] + q[1]) + (q[2] + q[3]); }
                        ss += __shfl_xor(ss, 16); ss += __shfl_xor(ss, 32);
                        const float f = rs * rsqrtf(ss * rs * rs * (1.0f / 32.0f) + EPS);
#pragma unroll
                        for (int n = 0; n < 2; ++n) { const f32x4 w = *(const GAS f32x4*)(wrp + 8 * fq + 4 * n);
                            const f32x4 cs = *(const GAS f32x4*)(cosT + (size_t)row * 16 + 8 * (fq & 1) + 4 * n), sn = *(const GAS f32x4*)(sinT + (size_t)row * 16 + 8 * (fq & 1) + 4 * n);
                            f32x4 o;
#pragma unroll
                            for (int e = 0; e < 4; ++e) { const float y = acc[ai][bj][m][n][e] * f * w[e]; const float pt = __shfl_xor(y, 32); o[e] = (y * cs[e] + sgn * pt * sn[e]) * c2; }
                            *(GAS u32x2*)(O + (size_t)row * ldo + (4 * bj + wc) * hw + 64 + 8 * fq + 4 * n) = (u32x2){cvt_pk_bf16(o[0], o[1]), cvt_pk_bf16(o[2], o[3])}; } }
                    asm volatile("" ::: "memory"); }
        }
    }
};
template <bool FIRST> struct EpiBranch { static constexpr bool PERM = true; bf16_t* O; const bf16_t* GL;
    __device__ __forceinline__ void operator()(const Acc& acc, const Unit& u, int wr, int wc, int fr, int fq) const {
        const int row0 = u.pm * BM + wr * 64 + fr, col0 = u.pn * BM + wc * 32 + 8 * fq;
#pragma unroll
        for (int ai = 0; ai < 2; ++ai)
#pragma unroll
            for (int m = 0; m < 4; ++m) { const size_t row = (size_t)(row0 + ai * HALF + m * 16);
#pragma unroll
                for (int bj = 0; bj < 2; ++bj) { const int c = col0 + bj * HALF;
                    const u32x4 gw = *(const GAS u32x4*)(GL + row * PROJ_LD + c);
                    f32x4 g0 = {bf_lo(gw.x), bf_hi(gw.x), bf_lo(gw.y), bf_hi(gw.y)}, g1 = {bf_lo(gw.z), bf_hi(gw.z), bf_lo(gw.w), bf_hi(gw.w)};
                    f32x4 o0, o1;
#pragma unroll
                    for (int e = 0; e < 4; ++e) { o0[e] = fast_sigmoid(g0[e]) * acc[ai][bj][m][0][e]; o1[e] = fast_sigmoid(g1[e]) * acc[ai][bj][m][1][e]; }
                    bf16_t* op = O + row * DM + c;
                    if (!FIRST) { const u32x4 ow = *(const GAS u32x4*)op;
                        o0 += (f32x4){bf_lo(ow.x), bf_hi(ow.x), bf_lo(ow.y), bf_hi(ow.y)}; o1 += (f32x4){bf_lo(ow.z), bf_hi(ow.z), bf_lo(ow.w), bf_hi(ow.w)}; }
                    *(GAS u32x4*)op = pack8(o0, o1); } }
    }
};
}

namespace att {
constexpr int KROW = 208, VROW = 144, KBUF = 64 * KROW, VBUF = 64 * VROW, V_OFF = 4 * KBUF;
constexpr float THR = 8.0f;
#define ATT_SB() __builtin_amdgcn_sched_barrier(0)
#define ATT_E(i) ((i) < 16 ? e0[(i) & 15] : e1[(i) & 15])
__device__ __forceinline__ float rowmax32(const f32x16& a, const f32x16& b) {
    float x = fmaxf(fmaxf(a[0], a[1]), b[0]), y = fmaxf(fmaxf(a[2], a[3]), b[1]); x = fmaxf(fmaxf(x, b[2]), b[3]);
#pragma unroll
    for (int r = 4; r < 16; r += 4) { x = fmaxf(fmaxf(x, a[r]), a[r + 1]); y = fmaxf(fmaxf(y, a[r + 2]), a[r + 3]); x = fmaxf(fmaxf(x, b[r]), b[r + 1]); y = fmaxf(fmaxf(y, b[r + 2]), b[r + 3]); }
    return fmaxf(x, y);
}
__device__ __forceinline__ void cmask(f32x16& p0, f32x16& p1, int kv0, int qidx, int hi) {
#pragma unroll
    for (int r = 0; r < 16; ++r) { const int kv = kv0 + (r & 3) + 8 * (r >> 2) + 4 * hi; if (kv > qidx) p0[r] = -INFINITY; if (kv + 32 > qidx) p1[r] = -INFINITY; }
}
template <int P> __device__ __forceinline__ void tile_iter(LAS unsigned char* lds, const int jt, const int NT, const int jmax, const int q0, const int qidx, const int hi,
        const unsigned ka, const unsigned va, const bf16_t* kn_src, const bf16_t* kr_src, const bf16_t* vt_src, const unsigned kn_dst, const unsigned kr_dst, const unsigned vt_dst, const bool has_r,
        const bf16x8 (&qr)[6], f32x16& o0, f32x16& o1, f32x16& negm, f32x16& s0, f32x16& s1, f32x16& e0, f32x16& e1, float& m_run, float& l_run,
        u32x4 (&gK)[2], u32x4 (&gR)[2], u32x4 (&gV)[2]) {
        { const unsigned nk = ((jt + 3) & 3) * KBUF, nv = ((jt + 2) & 3) * VBUF;
          *(LAS u32x4*)(lds + nk + kn_dst) = gK[P]; *(LAS u32x4*)(lds + nk + kr_dst) = gR[P];
          *(LAS u32x2*)(lds + nv + vt_dst) = (u32x2){gV[P].x, gV[P].y}; *(LAS u32x2*)(lds + nv + vt_dst + 16) = (u32x2){gV[P].z, gV[P].w};
          const int tk = (jt + 5 < NT) ? jt + 5 : NT - 1, tv = (jt + 4 < NT) ? jt + 4 : NT - 1;
          gK[P] = *(const GAS u32x4*)(kn_src + (size_t)tk * 64 * 512); gR[P] = *(const GAS u32x4*)(kr_src + (size_t)tk * 64 * 32); gV[P] = *(const GAS u32x4*)(vt_src + (size_t)tv * 64); }
        if (jt <= jmax) {
            const bool nx = jt + 1 <= jmax;
            const unsigned kb = ((jt + 1) & 3) * KBUF + ka, vb = (jt & 3) * VBUF + va;
            u32x4 pf[4]; float sacc = 0.f;
            {
                bf16x8 kf0 = *(const LAS bf16x8*)(lds + kb), kf1 = *(const LAS bf16x8*)(lds + kb + 32 * KROW), kn0 = kf0, kn1 = kf1;
#pragma unroll
                for (int ks = 0; ks < 6; ++ks) {
                    if (ks < 5) { kn0 = *(const LAS bf16x8*)(lds + kb + (ks + 1) * 32); kn1 = *(const LAS bf16x8*)(lds + kb + 32 * KROW + (ks + 1) * 32); }
                    s0 = __builtin_amdgcn_mfma_f32_32x32x16_bf16(kf0, qr[ks], ks == 0 ? negm : s0, 0, 0, 0);
#pragma unroll
                    for (int i = (16 * ks) / 3; i < (16 * ks + 8) / 3; ++i) sacc += ATT_E(i);
#pragma unroll
                    for (int c = (8 * ks) / 3; c < (8 * ks + 4) / 3; ++c) pf[c >> 2][c & 3] = cvt_pk_bf16(ATT_E(2 * c), ATT_E(2 * c + 1));
                    ATT_SB();
                    s1 = __builtin_amdgcn_mfma_f32_32x32x16_bf16(kf1, qr[ks], ks == 0 ? negm : s1, 0, 0, 0);
#pragma unroll
                    for (int i = (16 * ks + 8) / 3; i < (16 * ks + 16) / 3; ++i) sacc += ATT_E(i);
#pragma unroll
                    for (int c = (8 * ks + 4) / 3; c < (8 * ks + 8) / 3; ++c) pf[c >> 2][c & 3] = cvt_pk_bf16(ATT_E(2 * c), ATT_E(2 * c + 1));
                    ATT_SB();
                    kf0 = kn0; kf1 = kn1;
                }
            }
            l_run += sacc;
            float fsc = 1.0f; bool resc = false;
            if (nx) {
                const int kv0 = (jt + 1) * 64;
                if (kv0 + 63 > q0) cmask(s0, s1, kv0, qidx, hi);
                float rm = rowmax32(s0, s1);
                if (__any(rm > THR)) {
                    rm = fmaxf(rm, __shfl_xor(rm, 32));
                    const float dl = fmaxf(rm, 0.f);
                    m_run += dl; fsc = __builtin_amdgcn_exp2f(-dl); l_run *= fsc; resc = true;
#pragma unroll
                    for (int r = 0; r < 16; ++r) { s0[r] -= dl; s1[r] -= dl; negm[r] = -m_run; }
                }
            }
            ATT_SB();
            {
#define ATT_VA(m) (vb + ((m) & 1) * 32 * VROW + ((m) >> 1) * 32)
                bf16x8 vq[3];
                vq[0] = *(const LAS bf16x8*)(lds + ATT_VA(0)); vq[1] = *(const LAS bf16x8*)(lds + ATT_VA(1));
#pragma unroll
                for (int m = 0; m < 8; ++m) {
                    if (m < 6) vq[(m + 2) % 3] = *(const LAS bf16x8*)(lds + ATT_VA(m + 2));
                    const bf16x8 vf = vq[m % 3];
                    const bf16x8 pb = __builtin_bit_cast(bf16x8, pf[m >> 1]);
                    if ((m & 1) == 0) o0 = __builtin_amdgcn_mfma_f32_32x32x16_bf16(vf, pb, o0, 0, 0, 0);
                    else o1 = __builtin_amdgcn_mfma_f32_32x32x16_bf16(vf, pb, o1, 0, 0, 0);
                    if (m < 4) {
#pragma unroll
                        for (int i = 4 * m; i < 4 * m + 4; ++i) e0[i] = __builtin_amdgcn_exp2f(s0[i]);
                        asm volatile("" : "+v"(e0));
                    } else {
#pragma unroll
                        for (int i = 4 * m - 16; i < 4 * m - 12; ++i) e1[i] = __builtin_amdgcn_exp2f(s1[i]);
                        asm volatile("" : "+v"(e1));
                    }
                    ATT_SB();
                }
#undef ATT_VA
            }
            if (resc) {
#pragma unroll
                for (int r = 0; r < 16; ++r) { o0[r] *= fsc; o1[r] *= fsc; }
            }
        }
        if (P == 1) __syncthreads();
}
__device__ __forceinline__ void unit(LAS unsigned char* lds, int b, int h, int qb, const bf16_t* Q, const bf16_t* KN, const bf16_t* KR, const bf16_t* VT, bf16_t* O) {
    const int tid = opq_tid(), lane = tid & 63, wid = __builtin_amdgcn_readfirstlane(tid >> 6), r32 = lane & 31, hi = lane >> 5;
    const size_t tok0 = (size_t)b * SEQ;
    const int q0 = qb * 256 + wid * 32, qidx = q0 + r32, NT = 4 * (qb + 1), jmax = (q0 + 31) >> 6;
    bf16x8 qr[6];
    { const bf16_t* qp = Q + (tok0 + qidx) * QLD + h * 96 + hi * 8;
#pragma unroll
      for (int ks = 0; ks < 6; ++ks) qr[ks] = *(const GAS bf16x8*)(qp + ks * 16); }
    const int krow = tid >> 3, kch = tid & 7, rrow = (tid >> 2) & 63, rch = tid & 3;
    const bf16_t* kn_src = KN + (tok0 + krow) * 512 + h * 64 + kch * 8;
    const bf16_t* kr_src = KR + (tok0 + rrow) * 32 + rch * 8;
    const bf16_t* vt_src = VT + (size_t)(h * 64 + krow) * T + tok0 + kch * 8;
    const unsigned kn_dst = krow * KROW + kch * 16, kr_dst = rrow * KROW + 128 + rch * 16, vt_dst = V_OFF + krow * VROW + (kch >> 1) * 32 + (kch & 1) * 8;
    const bool has_r = tid < 256;
    u32x4 gk, gr = {0u, 0u, 0u, 0u}, gv;
    u32x4 gK[2], gR[2], gV[2];
    gK[0] = gr; gK[1] = gr; gR[0] = gr; gR[1] = gr; gV[0] = gr; gV[1] = gr;
    {
        gk = *(const GAS u32x4*)kn_src; gr = *(const GAS u32x4*)kr_src; gv = *(const GAS u32x4*)vt_src;
        const u32x4 gk1 = *(const GAS u32x4*)(kn_src + (size_t)64 * 512), gr1 = *(const GAS u32x4*)(kr_src + (size_t)64 * 32), gv1 = *(const GAS u32x4*)(vt_src + 64);
        const u32x4 gk2 = *(const GAS u32x4*)(kn_src + (size_t)2 * 64 * 512), gr2 = *(const GAS u32x4*)(kr_src + (size_t)2 * 64 * 32);
        gK[0] = *(const GAS u32x4*)(kn_src + (size_t)3 * 64 * 512); gR[0] = *(const GAS u32x4*)(kr_src + (size_t)3 * 64 * 32); gV[0] = *(const GAS u32x4*)(vt_src + (size_t)2 * 64);
        { const int t4 = NT > 4 ? 4 : 3; gK[1] = *(const GAS u32x4*)(kn_src + (size_t)t4 * 64 * 512); gR[1] = *(const GAS u32x4*)(kr_src + (size_t)t4 * 64 * 32); gV[1] = *(const GAS u32x4*)(vt_src + (size_t)3 * 64); }
        *(LAS u32x4*)(lds + kn_dst) = gk; *(LAS u32x4*)(lds + kr_dst) = gr;
        *(LAS u32x2*)(lds + vt_dst) = (u32x2){gv.x, gv.y}; *(LAS u32x2*)(lds + vt_dst + 16) = (u32x2){gv.z, gv.w};
        *(LAS u32x4*)(lds + KBUF + kn_dst) = gk1; *(LAS u32x4*)(lds + KBUF + kr_dst) = gr1;
        *(LAS u32x2*)(lds + VBUF + vt_dst) = (u32x2){gv1.x, gv1.y}; *(LAS u32x2*)(lds + VBUF + vt_dst + 16) = (u32x2){gv1.z, gv1.w};
        *(LAS u32x4*)(lds + 2 * KBUF + kn_dst) = gk2; *(LAS u32x4*)(lds + 2 * KBUF + kr_dst) = gr2;
    }
    __syncthreads();
    const unsigned ka = r32 * KROW + hi * 16;
    const unsigned va = V_OFF + r32 * VROW + hi * 16;
    f32x16 o0, o1, negm, s0, s1, e0, e1;
#pragma unroll
    for (int r = 0; r < 16; ++r) { o0[r] = 0.f; o1[r] = 0.f; s0[r] = 0.f; s1[r] = 0.f; }
    float m_run, l_run = 0.f;
    {
#pragma unroll
        for (int ks = 0; ks < 6; ++ks) {
            const bf16x8 k0 = *(const LAS bf16x8*)(lds + ka + ks * 32), k1 = *(const LAS bf16x8*)(lds + ka + 32 * KROW + ks * 32);
            s0 = __builtin_amdgcn_mfma_f32_32x32x16_bf16(k0, qr[ks], s0, 0, 0, 0);
            s1 = __builtin_amdgcn_mfma_f32_32x32x16_bf16(k1, qr[ks], s1, 0, 0, 0);
        }
        if (63 > q0) cmask(s0, s1, 0, qidx, hi);
        float rm = rowmax32(s0, s1); rm = fmaxf(rm, __shfl_xor(rm, 32));
        m_run = rm;
#pragma unroll
        for (int r = 0; r < 16; ++r) { e0[r] = __builtin_amdgcn_exp2f(s0[r] - rm); e1[r] = __builtin_amdgcn_exp2f(s1[r] - rm); negm[r] = -rm; }
    }
    __syncthreads();
    for (int jt = 0; jt < NT; jt += 2) {
        tile_iter<0>(lds, jt, NT, jmax, q0, qidx, hi, ka, va, kn_src, kr_src, vt_src, kn_dst, kr_dst, vt_dst, has_r, qr, o0, o1, negm, s0, s1, e0, e1, m_run, l_run, gK, gR, gV);
        tile_iter<1>(lds, jt + 1, NT, jmax, q0, qidx, hi, ka, va, kn_src, kr_src, vt_src, kn_dst, kr_dst, vt_dst, has_r, qr, o0, o1, negm, s0, s1, e0, e1, m_run, l_run, gK, gR, gV);
    }
    const float lt = l_run + __shfl_xor(l_run, 32);
    const float inv = 1.0f / lt;
    bf16_t* op = O + (tok0 + qidx) * 512 + h * 64 + 4 * hi;
#pragma unroll
    for (int g = 0; g < 4; ++g) {
        *(GAS u32x2*)(op + 8 * g) = (u32x2){cvt_pk_bf16(o0[4 * g] * inv, o0[4 * g + 1] * inv), cvt_pk_bf16(o0[4 * g + 2] * inv, o0[4 * g + 3] * inv)};
        *(GAS u32x2*)(op + 32 + 8 * g) = (u32x2){cvt_pk_bf16(o1[4 * g] * inv, o1[4 * g + 1] * inv), cvt_pk_bf16(o1[4 * g + 2] * inv, o1[4 * g + 3] * inv)};
    }
}
__device__ __forceinline__ void phase(LAS unsigned char* lds, const bf16_t* Q, const bf16_t* KN, const bf16_t* KR, const bf16_t* VT, bf16_t* O) {
    for (int j = blockIdx.x; j < 2048; j += gridDim.x) {
        const int bh = j & 63, qslot = j >> 6, k = qslot >> 2, s = qslot & 3, i = k >> 1;
        const int qb = (k & 1) ? 31 - (4 * i + s) : 4 * i + s;
        unit(lds, bh >> 3, bh & 7, qb, Q, KN, KR, VT, O);
    }
}
#undef ATT_SB
#undef ATT_E
}

__device__ __forceinline__ int src_col(int map, int n0) {
    const int pn = n0 >> 8, bj = (n0 >> 7) & 1, wc = (n0 >> 5) & 3;
    switch (map) {
        case 1: return bj * FF + 128 * pn + (n0 & 127);
        case 2: return pn < 2 ? 96 * (4 * pn + wc) + 32 * bj : 96 * (4 * bj + wc) + 64;
        case 3: return 128 * (4 * pn + wc) + 32 * bj;
        case 4: return 128 * (n0 >> 6) + 64 + (n0 & 63);
        case 5: return n0 < 4000 ? n0 : -1;
        default: return n0;
    }
}
__device__ __forceinline__ void tr_item(const float* W, int K, int pitch, bf16_t* WT, const float* scale, int map, int nblk, LAS float* scr, int item, int lane) {
    const int kb = item / nblk, nb = item % nblk, k0 = 64 * kb, n0 = 32 * nb;
    const int sc0 = src_col(map, n0);
#pragma unroll 8
    for (int i = 0; i < 32; ++i) { const int kk = 2 * i + (lane >> 5); float v = 0.f;
        if (sc0 >= 0) { v = ((const GAS float*)W)[(size_t)(k0 + kk) * pitch + sc0 + (lane & 31)]; if (scale) v *= ((const GAS float*)scale)[k0 + kk]; }
        scr[kk * 33 + (lane & 31)] = v; }
    asm volatile("s_waitcnt lgkmcnt(0)" ::: "memory");
    const int c = lane & 7;
#pragma unroll
    for (int j = 0; j < 4; ++j) { const int n = (lane >> 3) + 8 * j; const LAS float* s = scr + (8 * c) * 33 + n;
        u32x4 o; o.x = cvt_pk_bf16(s[0 * 33], s[1 * 33]); o.y = cvt_pk_bf16(s[2 * 33], s[3 * 33]); o.z = cvt_pk_bf16(s[4 * 33], s[5 * 33]); o.w = cvt_pk_bf16(s[6 * 33], s[7 * 33]);
        *(GAS u32x4*)(WT + (size_t)(n0 + n) * K + k0 + 8 * c) = o; }
    asm volatile("s_waitcnt lgkmcnt(0)" ::: "memory");
}

struct Args { const void* in[20]; float* out; unsigned char* ws; int ph_lo, ph_hi; };

__device__ __forceinline__ void gemv64(const LAS float* sc, LAS float* red, const float* W, int pitch, int n0, int nvalid, const float* bias, float* out, int ldo, int tid) {
    const int lane = tid & 63, wid = tid >> 6, n = n0 + lane; const bool valid = n < nvalid;
    const GAS float* Wg = (const GAS float*)W + (valid ? n : 0);
    float acc[8];
#pragma unroll
    for (int b = 0; b < 8; ++b) acc[b] = 0.f;
#pragma unroll 16
    for (int kk = 0; kk < 128; ++kk) { const int k = wid * 128 + kk; const float w = Wg[(size_t)k * pitch];
#pragma unroll
        for (int b = 0; b < 8; ++b) acc[b] += sc[b * 1024 + k] * w; }
#pragma unroll
    for (int b = 0; b < 8; ++b) red[(wid * 8 + b) * 64 + lane] = acc[b];
    __syncthreads();
    { float sum = (bias && valid) ? ((const GAS float*)bias)[n] : 0.f;
#pragma unroll
      for (int w = 0; w < 8; ++w) sum += red[(w * 8 + wid) * 64 + lane];
      ((GAS float*)out)[(size_t)wid * ldo + n] = valid ? sum : 0.f; }
    __syncthreads();
}
__device__ __forceinline__ void xa_phase(const Args& A, LAS unsigned char* lds) {
    const int tid = opq_tid(), lane = tid & 63, wid = tid >> 6;
    unsigned char* ws = opq(A.ws);
    const float* mod = (const float*)(ws + WS_MOD);
    const float* normw = (const float*)A.in[5];
    {
        LAS float* sc = (LAS float*)lds; LAS float* red = (LAS float*)(lds + 32768);
        for (int it = blockIdx.x; it < 240; it += gridDim.x) {
            int sub, g; const float* W; int pitch, nvalid, ldo; float* out;
            if (it < 88) { sub = 0; g = it; W = (const float*)A.in[6]; pitch = 2 * FF; nvalid = 2 * FF; ldo = 2 * FF; out = (float*)(ws + WS_SHW0); }
            else if (it < 152) { sub = 1; g = it - 88; W = (const float*)A.in[8]; pitch = 4000; nvalid = 4000; ldo = PROJ_LD; out = (float*)(ws + WS_SHW1); }
            else { sub = 2; g = it - 152; W = (const float*)A.in[6] + (size_t)DM * 2 * FF; pitch = 2 * FF; nvalid = 2 * FF; ldo = 2 * FF; out = (float*)(ws + WS_SHW2); }
            for (int i = tid; i < 8192; i += 512) sc[i] = ((const GAS float*)mod)[(size_t)(i >> 10) * MODLD + sub * 3072 + (i & 1023)];
            __syncthreads();
            gemv64(sc, red, W, pitch, g * 64, nvalid, nullptr, out, ldo, tid);
        }
        if ((int)blockIdx.x == (int)gridDim.x - 1) {
            float* av = (float*)(ws + WS_AVEC);
            for (int i = tid; i < 2 * 8 * 1024; i += 512) { const int sb = i >> 13, b = (i >> 10) & 7, c = i & 1023;
                ((GAS float*)av)[i] = ((const GAS float*)normw)[(sb + 1) * 1024 + c] * (1.0f + ((const GAS float*)mod)[(size_t)b * MODLD + (sb + 1) * 3072 + 1024 + c]); }
        }
    }
    const float* X = (const float*)A.in[0]; bf16_t* XA = (bf16_t*)(ws + WS_H); float* ssp = (float*)(ws + WS_SSP);
    const int gw = blockIdx.x * 8 + wid, NGW = gridDim.x * 8;
    for (int ch = gw; ch < T / 32; ch += NGW) {
        const int row0 = ch * 32, b = row0 / SEQ;
        const float* scp = mod + (size_t)b * MODLD + 1024;
        f32x4 a[4];
#pragma unroll
        for (int j = 0; j < 4; ++j) { const int c = 4 * lane + 256 * j; a[j] = *(const GAS f32x4*)(normw + c) * (*(const GAS f32x4*)(scp + c) + 1.0f); }
        f32x4 vn[4];
        { const float* xr = X + (size_t)row0 * DM + 4 * lane;
#pragma unroll
          for (int j = 0; j < 4; ++j) vn[j] = *(const GAS f32x4*)(xr + 256 * j); }
        for (int r = 0; r < 32; ++r) {
            f32x4 v[4]; float ss = 0.f;
#pragma unroll
            for (int j = 0; j < 4; ++j) v[j] = vn[j];
            if (r < 31) { const float* xr = X + (size_t)(row0 + r + 1) * DM + 4 * lane;
#pragma unroll
                for (int j = 0; j < 4; ++j) vn[j] = *(const GAS f32x4*)(xr + 256 * j); }
#pragma unroll
            for (int j = 0; j < 4; ++j) { const f32x4 q = v[j] * v[j]; ss += (q[0] + q[1]) + (q[2] + q[3]); }
            ss = wave_sum(ss);
            bf16_t* hr = XA + (size_t)(row0 + r) * DM + 4 * lane;
#pragma unroll
            for (int j = 0; j < 4; ++j) { const f32x4 o = v[j] * a[j]; *(GAS u32x2*)(hr + 256 * j) = (u32x2){cvt_pk_bf16(o[0], o[1]), cvt_pk_bf16(o[2], o[3])}; }
            if (lane < 16) ((GAS float*)ssp)[(size_t)(row0 + r) * 16 + lane] = lane == 0 ? ss : 0.f;
        }
    }
}

__device__ __forceinline__ void unpack8(const u32x4 w, float (&f)[8]) { f[0] = bf_lo(w.x); f[1] = bf_hi(w.x); f[2] = bf_lo(w.y); f[3] = bf_hi(w.y); f[4] = bf_lo(w.z); f[5] = bf_hi(w.z); f[6] = bf_lo(w.w); f[7] = bf_hi(w.w); }

__device__ __forceinline__ void conv_phase(const bf16_t* P, const float* convw, const float* krw, const float* cosT, const float* sinT, float* rstdq, float* rstdkv, bf16_t* KR, bf16_t* OC) {
    const int tid = opq_tid(), lane = tid & 63, gw = blockIdx.x * 8 + (tid >> 6), NGW = gridDim.x * 8;
    float w0[8], w1[8], w2[8];
#pragma unroll
    for (int e = 0; e < 8; ++e) { w0[e] = convw[8 * lane + e]; w1[e] = convw[512 + 8 * lane + e]; w2[e] = convw[1024 + 8 * lane + e]; }
    const int kl = (lane - 48) & 3;
    float kw[8];
#pragma unroll
    for (int e = 0; e < 8; ++e) kw[e] = krw[8 * kl + e];
    for (int ch = gw; ch < T / 32; ch += NGW) {
        const int row0 = ch * 32, s0 = row0 % SEQ;
        float um2[8], um1[8];
#pragma unroll
        for (int e = 0; e < 8; ++e) { um2[e] = 0.f; um1[e] = 0.f; }
        if (s0 > 0) {
            float a[8], c[8];
            unpack8(*(const GAS u32x4*)(P + (size_t)(row0 - 2) * PROJ_LD + C_CONV + 8 * lane), a); unpack8(*(const GAS u32x4*)(P + (size_t)(row0 - 2) * PROJ_LD + C_GC + 8 * lane), c);
#pragma unroll
            for (int e = 0; e < 8; ++e) um2[e] = a[e] * c[e];
            unpack8(*(const GAS u32x4*)(P + (size_t)(row0 - 1) * PROJ_LD + C_CONV + 8 * lane), a); unpack8(*(const GAS u32x4*)(P + (size_t)(row0 - 1) * PROJ_LD + C_GC + 8 * lane), c);
#pragma unroll
            for (int e = 0; e < 8; ++e) um1[e] = a[e] * c[e];
        }
        u32x4 nxv, ngb, ngc, nst = {0u, 0u, 0u, 0u};
        { const bf16_t* pr = P + (size_t)row0 * PROJ_LD;
          nxv = *(const GAS u32x4*)(pr + C_CONV + 8 * lane); ngb = *(const GAS u32x4*)(pr + C_GB + 8 * lane); ngc = *(const GAS u32x4*)(pr + C_GC + 8 * lane);
          if (lane < 52) nst = *(const GAS u32x4*)(pr + 8 * lane); }
        for (int r = 0; r < 32; ++r) {
            const size_t row = (size_t)(row0 + r);
            float xv[8], gb[8], gc[8], st[8];
            unpack8(nxv, xv); unpack8(ngb, gb); unpack8(ngc, gc); unpack8(nst, st);
            if (r < 31) { const bf16_t* pr = P + (row + 1) * PROJ_LD;
                nxv = *(const GAS u32x4*)(pr + C_CONV + 8 * lane); ngb = *(const GAS u32x4*)(pr + C_GB + 8 * lane); ngc = *(const GAS u32x4*)(pr + C_GC + 8 * lane);
                if (lane < 52) nst = *(const GAS u32x4*)(pr + 8 * lane); }
            float o[8];
#pragma unroll
            for (int e = 0; e < 8; ++e) { const float u = gc[e] * xv[e]; o[e] = gb[e] * (w0[e] * um2[e] + w1[e] * um1[e] + w2[e] * u); um2[e] = um1[e]; um1[e] = u; }
            *(GAS u32x4*)(OC + row * 512 + 8 * lane) = (u32x4){cvt_pk_bf16(o[0], o[1]), cvt_pk_bf16(o[2], o[3]), cvt_pk_bf16(o[4], o[5]), cvt_pk_bf16(o[6], o[7])};
            float ss = 0.f;
#pragma unroll
            for (int e = 0; e < 8; ++e) ss += st[e] * st[e];
            const float sq = wave_sum(lane < 32 ? ss : 0.f), skv = wave_sum((lane >= 32 && lane < 48) ? ss : 0.f), skr = wave_sum((lane >= 48 && lane < 52) ? ss : 0.f);
            { const float rn = lane < 32 ? rsqrtf(sq * (1.0f / 256.0f) + EPS) : rsqrtf(skv * (1.0f / 128.0f) + EPS);
              if (lane < 48) *(GAS u32x4*)((bf16_t*)P + row * PROJ_LD + 8 * lane) = (u32x4){cvt_pk_bf16(st[0] * rn, st[1] * rn), cvt_pk_bf16(st[2] * rn, st[3] * rn), cvt_pk_bf16(st[4] * rn, st[5] * rn), cvt_pk_bf16(st[6] * rn, st[7] * rn)}; }
            const float rk = rsqrtf(skr * (1.0f / 32.0f) + EPS);
            const f32x4 c0 = *(const GAS f32x4*)(cosT + row * 16 + 8 * (kl & 1)), c1 = *(const GAS f32x4*)(cosT + row * 16 + 8 * (kl & 1) + 4);
            const f32x4 s0v = *(const GAS f32x4*)(sinT + row * 16 + 8 * (kl & 1)), s1v = *(const GAS f32x4*)(sinT + row * 16 + 8 * (kl & 1) + 4);
            const float sgn = (kl < 2) ? -1.0f : 1.0f;
            float ko[8];
#pragma unroll
            for (int e = 0; e < 8; ++e) { const float y = st[e] * rk * kw[e]; const float pt = __shfl_xor(y, 2);
                const float cc = e < 4 ? c0[e & 3] : c1[e & 3], sn = e < 4 ? s0v[e & 3] : s1v[e & 3]; ko[e] = y * cc + sgn * pt * sn; }
            if (lane >= 48 && lane < 52) *(GAS u32x4*)(KR + row * 32 + 8 * kl) = (u32x4){cvt_pk_bf16(ko[0], ko[1]), cvt_pk_bf16(ko[2], ko[3]), cvt_pk_bf16(ko[4], ko[5]), cvt_pk_bf16(ko[6], ko[7])};
        }
    }
}

__device__ const float INV_FREQ[16] = {1.0f, 0.5623413324356079f, 0.3162277638912201f, 0.17782793939113617f, 0.10000000149011612f, 0.05623412877321243f, 0.03162277862429619f, 0.017782794311642647f,
    0.009999999776482582f, 0.005623413249850273f, 0.003162277862429619f, 0.0017782794311642647f, 0.0010000000474974513f, 0.000562341301701963f, 0.0003162277862429619f, 0.00017782794020604342f};

__device__ __forceinline__ void sincos_reduced(float ang, float& s, float& c) {
    const double x = (double)ang;
    const double k = __builtin_rint(x * 0.15915494309189535);
    const float r = (float)(x - k * 6.283185307179586);
    s = __sinf(r); c = __cosf(r);
}

__device__ __forceinline__ void prologue(const Args& A, LAS unsigned char* lds) {
    const int tid = opq_tid(), lane = tid & 63, wid = tid >> 6;
    unsigned char* ws = opq(A.ws);
    {
        LAS float* sc = (LAS float*)lds; LAS float* red = (LAS float*)(lds + 32768);
        const float* c = (const float*)A.in[1];
        if ((int)blockIdx.x < 144) {
            for (int i = tid; i < 8192; i += 512) { const float v = ((const GAS float*)c)[i]; sc[i] = v / (1.0f + __expf(-v)); }
            __syncthreads();
        }
        for (int cgp = blockIdx.x; cgp < 144; cgp += gridDim.x)
            gemv64(sc, red, (const float*)A.in[3], MODLD, cgp * 64, MODLD, (const float*)A.in[4], (float*)(ws + WS_MOD), MODLD, tid);
    }
    __syncthreads();
    {
        const int* pos = (const int*)A.in[2]; float* cosT = (float*)(ws + WS_COS); float* sinT = (float*)(ws + WS_SIN);
        for (int idx = blockIdx.x * 512 + tid; idx < T * 16; idx += gridDim.x * 512) {
            const float ang = (float)((const GAS int*)pos)[idx >> 4] * INV_FREQ[idx & 15]; float s, c; sincos_reduced(ang, s, c); ((GAS float*)cosT)[idx] = c; ((GAS float*)sinT)[idx] = s; }
    }
    {
        LAS float* scr = (LAS float*)(lds + wid * 16384);
        const int gw = blockIdx.x * 8 + wid, NGW = gridDim.x * 8;
        const float* w13 = (const float*)A.in[6]; const float* w2 = (const float*)A.in[7]; const float* win = (const float*)A.in[8];
        const float* qan = (const float*)A.in[9]; const float* wuq = (const float*)A.in[10]; const float* kvan = (const float*)A.in[11]; const float* wukv = (const float*)A.in[12];
        const float* wbr = (const float*)A.in[18]; const float* wout = (const float*)A.in[19];
        constexpr int I13 = 16 * 176, I2 = 44 * 32, IIN = 16 * 128, IUQ = 4 * 24, IUK = 2 * 16, IV = 2 * 16, IB = 8 * 32, IO = 16 * 32;
        constexpr int NIT = 2 * I13 + 2 * I2 + IIN + IUQ + IUK + IV + 2 * IB + IO;
        for (int it = gw; it < NIT; it += NGW) {
            int r = it;
            if (r < I13) { tr_item(w13, 1024, 5632, (bf16_t*)(ws + WS_W13A), nullptr, 1, 176, scr, r, lane); continue; } r -= I13;
            if (r < I13) { tr_item(w13 + (size_t)1024 * 5632, 1024, 5632, (bf16_t*)(ws + WS_W13B), nullptr, 1, 176, scr, r, lane); continue; } r -= I13;
            if (r < I2) { tr_item(w2, 2816, 1024, (bf16_t*)(ws + WS_W2A), nullptr, 0, 32, scr, r, lane); continue; } r -= I2;
            if (r < I2) { tr_item(w2 + (size_t)2816 * 1024, 2816, 1024, (bf16_t*)(ws + WS_W2B), nullptr, 0, 32, scr, r, lane); continue; } r -= I2;
            if (r < IIN) { tr_item(win, 1024, 4000, (bf16_t*)(ws + WS_WIN), nullptr, 5, 128, scr, r, lane); continue; } r -= IIN;
            if (r < IUQ) { tr_item(wuq, 256, 768, (bf16_t*)(ws + WS_WUQ), qan, 2, 24, scr, r, lane); continue; } r -= IUQ;
            if (r < IUK) { tr_item(wukv, 128, 1024, (bf16_t*)(ws + WS_WUK), kvan, 3, 16, scr, r, lane); continue; } r -= IUK;
            if (r < IV) { tr_item(wukv, 128, 1024, (bf16_t*)(ws + WS_WV), kvan, 4, 16, scr, r, lane); continue; } r -= IV;
            if (r < IB) { tr_item(wbr, 512, 1024, (bf16_t*)(ws + WS_WB0), nullptr, 0, 32, scr, r, lane); continue; } r -= IB;
            if (r < IB) { tr_item(wbr + (size_t)512 * 1024, 512, 1024, (bf16_t*)(ws + WS_WB1), nullptr, 0, 32, scr, r, lane); continue; } r -= IB;
            tr_item(wout, 1024, 1024, (bf16_t*)(ws + WS_WOUT), nullptr, 0, 32, scr, r, lane);
        }
    }
    __syncthreads();
}

#define XB_TMO      128
#define XB_XCNT(j)  (256  + 64 * (j))
#define XB_XSUB(j)  (1280 + 64 * (j))
#define XB_XGEN(j)  (2304 + 64 * (j))
#define XB_TOP      3328
#define XB_TOPGEN   3392
#define XCD_BAR_WORDS 3456
#define XB_SPIN_CAP (1u << 22)
__device__ __forceinline__ unsigned xb_ld(unsigned* p)              { return __hip_atomic_load(p, __ATOMIC_RELAXED, __HIP_MEMORY_SCOPE_AGENT); }
__device__ __forceinline__ unsigned xb_add(unsigned* p, unsigned v) { return __hip_atomic_fetch_add(p, v, __ATOMIC_RELAXED, __HIP_MEMORY_SCOPE_AGENT); }
__device__ __forceinline__ unsigned xb_xcc_id() { return (unsigned)__builtin_amdgcn_s_getreg((3 << 11) | 20) & 0xFu; }
#define XB_SPIN(cond, bar) do { unsigned _sp = 0; while (cond) { __builtin_amdgcn_s_sleep(1); \
    if ((++_sp & 255u) == 0u) { if (xb_ld(&(bar)[XB_TMO])) break; if (_sp > XB_SPIN_CAP) { atomicAdd(&(bar)[XB_TMO], 1u); break; } } } } while (0)
struct XcdBarrier { unsigned* bar; unsigned x; volatile LAS unsigned* st; };
__device__ __forceinline__ XcdBarrier xcd_barrier_post(unsigned* bar, volatile LAS unsigned* st, int tid) {
    XcdBarrier b; b.bar = bar; b.x = xb_xcc_id(); b.st = st;
    if (tid == 0) (void)xb_add(&bar[XB_XCNT(b.x)], 1u);
    return b;
}
__device__ __forceinline__ void xcd_barrier_complete(unsigned* bar, unsigned x, unsigned& nloc, unsigned& nx) {
    const unsigned G = gridDim.x;
    unsigned sum, cnt, mine, sp = 0u;
    for (;;) {
        sum = 0u; cnt = 0u; mine = 0u;
#pragma unroll
        for (unsigned j = 0; j < 16; ++j) { const unsigned c = xb_ld(&bar[XB_XCNT(j)]); sum += c; cnt += (c > 0u) ? 1u : 0u; mine = (j == x) ? c : mine; }
        if (sum == G) break;
        __builtin_amdgcn_s_sleep(1);
        if ((++sp & 255u) == 0u) { if (xb_ld(&bar[XB_TMO])) break; if (sp > XB_SPIN_CAP) { atomicAdd(&bar[XB_TMO], 1u); break; } }
    }
    nloc = mine > 0u ? mine : 1u; nx = cnt > 0u ? cnt : 1u;
}
__device__ __forceinline__ void xcd_barrier(const XcdBarrier& b) {
    asm volatile("s_waitcnt vmcnt(0)" ::: "memory");
    __syncthreads();
    if (opq_tid() == 0) {
        unsigned* bar = b.bar;
        __builtin_amdgcn_s_waitcnt(0);
        unsigned nloc = b.st[0], nx = b.st[1];
        if (nloc == 0u) { xcd_barrier_complete(bar, b.x, nloc, nx); b.st[0] = nloc; b.st[1] = nx; }
        const unsigned old = xb_add(&bar[XB_XSUB(b.x)], 1u);
        const unsigned gen = old / nloc;
        if (old + 1u == (gen + 1u) * nloc) {
            __builtin_amdgcn_fence(__ATOMIC_RELEASE, "agent");
            asm volatile("s_waitcnt vmcnt(0)" ::: "memory");
            const unsigned og = xb_add(&bar[XB_TOP], 1u);
            const unsigned tg = og / nx;
            if (og + 1u == (tg + 1u) * nx) xb_add(&bar[XB_TOPGEN], 1u);
            else XB_SPIN(xb_ld(&bar[XB_TOPGEN]) == tg, bar);
            __builtin_amdgcn_fence(__ATOMIC_ACQUIRE, "agent");
            xb_add(&bar[XB_XGEN(b.x)], 1u);
            asm volatile("s_waitcnt vmcnt(0)" ::: "memory");
        } else {
            XB_SPIN(xb_ld(&bar[XB_XGEN(b.x)]) == gen, bar);
            __builtin_amdgcn_fence(__ATOMIC_ACQUIRE, "agent");
            asm volatile("s_waitcnt vmcnt(0)" ::: "memory");
        }
    }
    __syncthreads();
}

#ifndef MK_PER_PHASE
#define MK_PER_PHASE 0
#endif
__global__ void __launch_bounds__(512) fwd_kernel(Args A) {
    extern __shared__ __attribute__((aligned(16))) unsigned char lds_raw[];
    LAS unsigned char* lds = (LAS unsigned char*)lds_raw;
    cg::grid_group grid = cg::this_grid();
    const int G = gridDim.x, cidx = blockIdx.x;
    { const int t0 = opq_tid(); if (t0 < 32) ((LAS unsigned*)(lds + LDS_MISC))[t0] = 0u; __syncthreads(); }
    if (blockIdx.x == 0) { GAS u32x4* bz = (GAS u32x4*)(opq(A.ws) + WS_BAR); const int t0 = opq_tid(); bz[t0] = (u32x4){0u, 0u, 0u, 0u}; bz[512 + t0] = (u32x4){0u, 0u, 0u, 0u}; }
    const int lo = A.ph_lo, hi = A.ph_hi; (void)lo; (void)hi;
#if MK_PER_PHASE
#define IN(k) (lo <= (k) && (k) < hi)
#define SEAM(k) do { } while (0)
#else
#define IN(k) true
#define SEAM(k) do { if ((k) == 0) grid.sync(); else { XcdBarrier xb_; xb_.bar = (unsigned*)(opq(A.ws) + WS_BAR); xb_.x = xb_xcc_id(); xb_.st = (volatile LAS unsigned*)(lds + LDS_MISC); xcd_barrier(xb_); } } while (0)
#endif
#define WSP(T_, off) ((T_*)(ws + (off)))
#ifndef DUP
#define DUP 0
#endif
#if DUP
#define REP(k) for (int rep_ = 0; rep_ <= ((DUP >> (k)) & 1); ++rep_)
#else
#define REP(k)
#endif
    using namespace pg8;

    REP(0) { if (IN(0)) { prologue(A, lds); } SEAM(0); }
    (void)xcd_barrier_post((unsigned*)(opq(A.ws) + WS_BAR), (volatile LAS unsigned*)(lds + LDS_MISC), opq_tid());
    REP(1) { if (IN(1)) { xa_phase(A, lds); } SEAM(1); }
    REP(2) { if (IN(2)) { unsigned char* ws = opq(A.ws); Gemm g{WSP(const bf16_t, WS_H), WSP(const bf16_t, WS_W13A), T, 2 * FF, DM, DM, DM}; StaticOrder S; S.init(T, 2 * FF, G, cidx);
        EpiSwiGLU E{WSP(bf16_t, WS_BIG), WSP(const float, WS_SSP), WSP(const float, WS_SHW0)}; gemm_phase<EpiSwiGLU, StaticOrder, true>(lds, g, S, E); } SEAM(2); }
    REP(3) { if (IN(3)) { unsigned char* ws = opq(A.ws); Gemm g{WSP(const bf16_t, WS_BIG), WSP(const bf16_t, WS_W2A), T, DM, FF, FF, FF}; StaticOrder S; S.init(T, DM, G, cidx);
        EpiResidN<0> E{opq((const float*)A.in[0]), opq(A.out), WSP(bf16_t, WS_H), WSP(float, WS_SSP), WSP(const float, WS_MOD) + 0 * 3072 + 2048, WSP(const float, WS_AVEC), 0.5f};
        gemm_phase<EpiResidN<0>, StaticOrder, true>(lds, g, S, E); } SEAM(3); }
    REP(5) { if (IN(5)) { unsigned char* ws = opq(A.ws); Gemm g{WSP(const bf16_t, WS_H), WSP(const bf16_t, WS_WIN), T, PROJ_LD, DM, DM, DM}; StaticOrder S; S.init(T, PROJ_LD, G, cidx);
        EpiProj E{WSP(bf16_t, WS_BIG), WSP(const float, WS_SSP), WSP(const float, WS_SHW1)}; gemm_phase<EpiProj, StaticOrder, true>(lds, g, S, E); } SEAM(5); }
    REP(6) { if (IN(6)) { unsigned char* ws = opq(A.ws); conv_phase(WSP(const bf16_t, WS_BIG), (const float*)A.in[17], (const float*)A.in[16], WSP(const float, WS_COS), WSP(const float, WS_SIN),
        WSP(float, WS_RSTDQ), WSP(float, WS_RSTDKV), WSP(bf16_t, WS_KR), WSP(bf16_t, WS_OCONV)); } SEAM(6); }
    REP(7) { if (IN(7)) {
        { unsigned char* ws = opq(A.ws); Gemm g{WSP(const bf16_t, WS_BIG), WSP(const bf16_t, WS_WUQ), T, 768, 256, PROJ_LD, 256}; StaticOrder S; S.init(T, 768, G, cidx);
          EpiQK<2> E{WSP(bf16_t, WS_Q), QLD, 96, WSP(const float, WS_RSTDQ), (const float*)A.in[13], (const float*)A.in[15], WSP(const float, WS_COS), WSP(const float, WS_SIN), QSCALE};
          gemm_phase<EpiQK<2>, StaticOrder, true>(lds, g, S, E); }
        { unsigned char* ws = opq(A.ws); Gemm g{WSP(const bf16_t, WS_BIG) + 256, WSP(const bf16_t, WS_WUK), T, 512, 128, PROJ_LD, 128}; StaticOrder S; S.init(T, 512, G, cidx);
          EpiQK<-1> E{WSP(bf16_t, WS_KN), 512, 64, WSP(const float, WS_RSTDKV), (const float*)A.in[14], nullptr, nullptr, nullptr, 1.0f};
          gemm_phase<EpiQK<-1>, StaticOrder, true>(lds, g, S, E); }
        { unsigned char* ws = opq(A.ws); Gemm g{WSP(const bf16_t, WS_WV), WSP(const bf16_t, WS_BIG) + 256, 512, T, 128, 128, PROJ_LD}; StaticOrder S; S.init(512, T, G, cidx);
          EpiVT E{WSP(bf16_t, WS_VT), WSP(const float, WS_RSTDKV)}; gemm_phase<EpiVT, StaticOrder, true>(lds, g, S, E); }
    } SEAM(7); }
    REP(8) { if (IN(8)) { unsigned char* ws = opq(A.ws); att::phase(lds, WSP(const bf16_t, WS_Q), WSP(const bf16_t, WS_KN), WSP(const bf16_t, WS_KR), WSP(const bf16_t, WS_VT), WSP(bf16_t, WS_OATT)); } SEAM(8); }
    REP(9) { if (IN(9)) {
        { unsigned char* ws = opq(A.ws); Gemm g{WSP(const bf16_t, WS_OATT), WSP(const bf16_t, WS_WB0), T, DM, 512, 512, 512}; StaticOrder S; S.init(T, DM, G, cidx);
          EpiBranch<true> E{WSP(bf16_t, WS_MERGED), WSP(const bf16_t, WS_BIG) + C_GL}; gemm_phase<EpiBranch<true>, StaticOrder, true>(lds, g, S, E); }
        { unsigned char* ws = opq(A.ws); Gemm g{WSP(const bf16_t, WS_OCONV), WSP(const bf16_t, WS_WB1), T, DM, 512, 512, 512}; StaticOrder S; S.init(T, DM, G, cidx);
          EpiBranch<false> E{WSP(bf16_t, WS_MERGED), WSP(const bf16_t, WS_BIG) + C_GL + 1024}; gemm_phase<EpiBranch<false>, StaticOrder, true>(lds, g, S, E); }
    } SEAM(9); }
    REP(10) { if (IN(10)) { unsigned char* ws = opq(A.ws); Gemm g{WSP(const bf16_t, WS_MERGED), WSP(const bf16_t, WS_WOUT), T, DM, DM, DM, DM}; StaticOrder S; S.init(T, DM, G, cidx);
        EpiResidN<1> E{opq(A.out), WSP(bf16_t, WS_X2B), WSP(bf16_t, WS_H), WSP(float, WS_SSP), WSP(const float, WS_MOD) + 1 * 3072 + 2048, WSP(const float, WS_AVEC) + 8 * 1024, 1.0f};
        gemm_phase<EpiResidN<1>, StaticOrder, true>(lds, g, S, E); } SEAM(10); }
    REP(12) { if (IN(12)) { unsigned char* ws = opq(A.ws); Gemm g{WSP(const bf16_t, WS_H), WSP(const bf16_t, WS_W13B), T, 2 * FF, DM, DM, DM}; StaticOrder S; S.init(T, 2 * FF, G, cidx);
        EpiSwiGLU E{WSP(bf16_t, WS_BIG), WSP(const float, WS_SSP), WSP(const float, WS_SHW2)}; gemm_phase<EpiSwiGLU, StaticOrder, true>(lds, g, S, E); } SEAM(12); }
    if (IN(13)) { unsigned char* ws = opq(A.ws); Gemm g{WSP(const bf16_t, WS_BIG), WSP(const bf16_t, WS_W2B), T, DM, FF, FF, FF}; StaticOrder S; S.init(T, DM, G, cidx);
        EpiResidN<2> E{WSP(const bf16_t, WS_X2B), opq(A.out), nullptr, nullptr, WSP(const float, WS_MOD) + 2 * 3072 + 2048, nullptr, 0.5f};
        gemm_phase<EpiResidN<2>, StaticOrder, true>(lds, g, S, E); }
#undef IN
#undef SEAM
#undef WSP
#undef REP
}

extern "C" void kernel_launch(void* const* d_in, const int* in_sizes, int n_in, void* d_out, int out_size, void* d_ws, size_t ws_size, hipStream_t stream) {
    static int grid = 0;
    if (grid == 0) {
        if (n_in != 20 || out_size != T * DM || ws_size < WS_END) { fprintf(stderr, "kernel_launch: unexpected shapes (n_in %d out %d ws %zu)\n", n_in, out_size, ws_size); grid = -1; return; }
        int dev = 0, cus = 0, per_cu = 0;
        hipGetDevice(&dev); hipDeviceGetAttribute(&cus, hipDeviceAttributeMultiprocessorCount, dev);
        if (hipFuncSetAttribute((const void*)fwd_kernel, hipFuncAttributeMaxDynamicSharedMemorySize, LDS_BYTES) != hipSuccess) { fprintf(stderr, "kernel_launch: hipFuncSetAttribute failed\n"); grid = -1; return; }
        if (hipOccupancyMaxActiveBlocksPerMultiprocessor(&per_cu, (const void*)fwd_kernel, 512, LDS_BYTES) != hipSuccess || per_cu < 1) per_cu = 1;
        (void)hipGetLastError();
        grid = cus * per_cu;
        if (grid > 256) grid = 256;
    }
    if (grid < 0) return;
    Args a{};
    for (int i = 0; i < 20; ++i) a.in[i] = d_in[i];
    a.out = (float*)d_out; a.ws = (unsigned char*)d_ws;
#if MK_PER_PHASE
    for (int p = 0; p < 14; ++p) { a.ph_lo = p; a.ph_hi = p + 1; hipLaunchKernelGGL(fwd_kernel, dim3(grid), dim3(512), LDS_BYTES, stream, a); }
#else
    a.ph_lo = 0; a.ph_hi = 14;
    void* args[] = {&a};
    hipError_t e = hipLaunchCooperativeKernel((const void*)fwd_kernel, dim3(grid), dim3(512), args, LDS_BYTES, stream);
    if (e != hipSuccess) fprintf(stderr, "cooperative launch failed: %s (grid %d)\n", hipGetErrorString(e), grid);
#endif
}
```

```cpp
#include <hip/hip_runtime.h>
#include <hip/hip_cooperative_groups.h>
#include <cstdio>
#include <cstdint>
namespace cg = cooperative_groups;

#define LAS __attribute__((address_space(3)))
#define GAS __attribute__((address_space(1)))
typedef unsigned short bf16_t;
typedef short bf16x8 __attribute__((ext_vector_type(8)));
typedef float f32x4 __attribute__((ext_vector_type(4)));
typedef float f32x16 __attribute__((ext_vector_type(16)));
typedef unsigned u32x4 __attribute__((ext_vector_type(4)));
typedef unsigned u32x2 __attribute__((ext_vector_type(2)));

constexpr int BATCH = 8, SEQ = 8192, T = BATCH * SEQ, DM = 1024, FF = 2816, NH = 8;
constexpr int QLD = 768, PROJ_LD = 4096, MODLD = 9216;
constexpr int C_CONV = 416, C_GB = 928, C_GC = 1440, C_GL = 1952;
constexpr float EPS = 1e-6f;
constexpr float QSCALE = 0.10206207261596577f * 1.4426950408889634f;

constexpr size_t MiB = 1u << 20;
constexpr size_t WS_MOD = 0, WS_RSTDQ = 1 * MiB, WS_RSTDKV = 1 * MiB + 512 * 1024, WS_COS = 2 * MiB, WS_SIN = 6 * MiB, WS_KR = 10 * MiB;
constexpr size_t WS_W13A = 16 * MiB, WS_W13B = 27 * MiB, WS_W2A = 38 * MiB, WS_W2B = 38 * MiB + 5632 * 1024, WS_WIN = 49 * MiB;
constexpr size_t WS_WUQ = 57 * MiB, WS_WUK = 57 * MiB + 512 * 1024, WS_WV = 57 * MiB + 768 * 1024, WS_WB0 = 58 * MiB, WS_WB1 = 59 * MiB, WS_WOUT = 60 * MiB;
constexpr size_t WS_H = 64 * MiB, WS_OATT = 64 * MiB, WS_OCONV = 128 * MiB;
constexpr size_t WS_BIG = 192 * MiB;
constexpr size_t WS_Q = 704 * MiB, WS_KN = 800 * MiB, WS_MERGED = 704 * MiB, WS_VT = 864 * MiB, WS_SSP = 928 * MiB, WS_END = 932 * MiB;
constexpr size_t WS_SHW0 = 14 * MiB, WS_SHW1 = 14 * MiB + 256 * 1024, WS_SHW2 = 14 * MiB + 512 * 1024, WS_AVEC = 14 * MiB + 768 * 1024;
constexpr size_t WS_X2B = 544 * MiB;

constexpr size_t WS_BAR = 15 * MiB, BAR_BYTES = 16384;
constexpr int LDS_BYTES = 147456, LDS_MISC = 131072 + 320;

template <class P> __device__ __forceinline__ P* opq(P* p) { asm volatile("" : "+s"(p)); return p; }
__device__ __forceinline__ int opq_tid() { int t = threadIdx.x; asm volatile("" : "+v"(t)); return t; }
__device__ __forceinline__ unsigned cvt_pk_bf16(float lo, float hi) { unsigned r; asm("v_cvt_pk_bf16_f32 %0, %1, %2" : "=v"(r) : "v"(lo), "v"(hi)); return r; }
__device__ __forceinline__ float bf_lo(unsigned w) { return __uint_as_float(w << 16); }
__device__ __forceinline__ float bf_hi(unsigned w) { return __uint_as_float(w & 0xffff0000u); }
__device__ __forceinline__ float fast_sigmoid(float x) { return __builtin_amdgcn_rcpf(1.0f + __expf(-x)); }
__device__ __forceinline__ u32x4 pack8(f32x4 a, f32x4 b) { u32x4 w; w.x = cvt_pk_bf16(a[0], a[1]); w.y = cvt_pk_bf16(a[2], a[3]); w.z = cvt_pk_bf16(b[0], b[1]); w.w = cvt_pk_bf16(b[2], b[3]); return w; }
__device__ __forceinline__ float wave_sum(float v) {
#pragma unroll
    for (int o = 1; o < 64; o <<= 1) v += __shfl_xor(v, o);
    return v;
}

namespace pg8 {
constexpr int BM = 256, BK = 64, HALF = 128, HTB = HALF * BK * 2, STAGE_BYTES = 8 * HTB, NXCD = 8, WGM = 8;
__host__ __device__ __forceinline__ int lds_byte(int r, int c) { const int st = (r >> 4) * 2 + (c >> 5), rr = r & 15, cc = c & 31, ob = rr * 64 + cc * 2; return st * 1024 + (ob ^ (((ob >> 9) & 1) << 5)); }
__host__ __device__ __forceinline__ void stage_rc(int b, int& R, int& C) { const int st = b / 1024, sb = b % 1024, swz = sb ^ (((sb >> 9) & 1) << 5); R = (st >> 1) * 16 + swz / 64; C = (st & 1) * 32 + (swz % 64) / 2; }
__host__ __device__ __forceinline__ int perm32(int rho) { const int n = rho >> 4, i = rho & 15; return 8 * (i >> 2) + 4 * n + (i & 3); }

struct Unit { int pm, pn; };
struct Gemm { const bf16_t* A; const bf16_t* Bt; int M, N, K, lda, ldb; };

struct StaticOrder {
    int nM, nN, nwg, G, c;
    __host__ __device__ void init(int M, int N, int G_, int c_) { nM = M / BM; nN = N / BM; nwg = nM * nN; G = G_; c = c_; }
    __host__ __device__ bool next(int i, Unit& u) const {
        const long L = (long)i * G + c; if (L >= nwg) return false;
        int wgid = (int)L; { const int q = nwg / NXCD, r = nwg % NXCD, xcd = wgid % NXCD, off = wgid / NXCD; wgid = (xcd < r ? xcd * (q + 1) : r * (q + 1) + (xcd - r) * q) + off; }
        const int nig = WGM * nN, gid = wgid / nig, fm = gid * WGM, gsz = (nM - fm) < WGM ? (nM - fm) : WGM;
        u.pm = fm + ((wgid % nig) % gsz); u.pn = (wgid % nig) / gsz; return true;
    }
};

template <class Epi, class Sched, bool ALIGN_EPI>
__device__ __forceinline__ void gemm_phase(LAS unsigned char* lds, const Gemm g, const Sched& S, const Epi& E) {
    int tid_ = threadIdx.x; asm volatile("" : "+v"(tid_));
    const int tid = tid_, wid = __builtin_amdgcn_readfirstlane(tid >> 6), lane = tid & 63, wr = wid >> 2, wc = wid & 3, fr = lane & 15, fq = lane >> 4;
    const int K = g.K, nt = K / BK;
    unsigned voffA[2], voffB[2];
#pragma unroll
    for (int i = 0; i < 2; ++i) { int R, C; stage_rc(tid * 16 + i * 8192, R, C); const int Rb = Epi::PERM ? ((R & ~31) + perm32(R & 31)) : R;
        voffA[i] = (unsigned)(R * g.lda + C) * 2u; voffB[i] = (unsigned)(Rb * g.ldb + C) * 2u; }
    const size_t kstep = (size_t)(BK * 2);
    const size_t hstepA = (size_t)HALF * g.lda * 2, hstepB = (size_t)HALF * g.ldb * 2;
    const size_t tstepA = 2 * hstepA, tstepB = 2 * hstepB;
    const unsigned ldsw = (unsigned)wid * 1024u;
    const int aoff = lds_byte(wr * 64 + fr, fq * 8), boff = lds_byte(wc * 32 + fr, fq * 8);
#define PG8_SA(b, h) (((b) * 2 + (h)) * HTB)
#define PG8_SB(b, h) ((4 + (b) * 2 + (h)) * HTB)
#define PG8_STAGE(bufoff, gbase, voff) do { _Pragma("unroll") for (int _i = 0; _i < 2; ++_i) \
        __builtin_amdgcn_global_load_lds((const unsigned*)((const char*)(gbase) + (voff)[_i]), (LAS unsigned*)(lds + (bufoff) + ldsw + _i * 8192), 16, 0, 0); } while (0)
#define PG8_LDA(dst, b, h) do { _Pragma("unroll") for (int m = 0; m < 4; ++m) _Pragma("unroll") for (int k = 0; k < 2; ++k) dst[m][k] = *(const LAS bf16x8*)(lds + PG8_SA(b, h) + aoff + m * 2048 + k * 1024); } while (0)
#define PG8_LDB(dst, b, h) do { _Pragma("unroll") for (int n = 0; n < 2; ++n) _Pragma("unroll") for (int k = 0; k < 2; ++k) dst[n][k] = *(const LAS bf16x8*)(lds + PG8_SB(b, h) + boff + n * 2048 + k * 1024); } while (0)
#define PG8_MMA(ai, bj, At, Bt) do { __builtin_amdgcn_s_setprio(1); _Pragma("unroll") for (int m = 0; m < 4; ++m) _Pragma("unroll") for (int n = 0; n < 2; ++n) _Pragma("unroll") for (int k = 0; k < 2; ++k) \
        acc[ai][bj][m][n] = __builtin_amdgcn_mfma_f32_16x16x32_bf16(Bt[n][k], At[m][k], acc[ai][bj][m][n], 0, 0, 0); __builtin_amdgcn_s_setprio(0); } while (0)
#define PG8_WAIT_V(n) asm volatile("s_waitcnt vmcnt(" #n ")" ::: "memory")
#define PG8_WAIT_L(n) asm volatile("s_waitcnt lgkmcnt(" #n ")" ::: "memory")
#define PG8_BAR __builtin_amdgcn_s_barrier()
#define PG8_SCHED __builtin_amdgcn_sched_barrier(0)
    Unit cur, nxt; int ui = 0;
    if (!S.next(0, cur)) return;
    f32x4 acc[2][2][4][2];
#pragma unroll
    for (int a = 0; a < 2; ++a)
#pragma unroll
        for (int b = 0; b < 2; ++b)
#pragma unroll
            for (int m = 0; m < 4; ++m)
#pragma unroll
                for (int n = 0; n < 2; ++n) acc[a][b][m][n] = (f32x4){0.f, 0.f, 0.f, 0.f};
    bf16x8 At[4][2], B0[2][2], B1[2][2];
    const char* cA = (const char*)g.A + (size_t)cur.pm * tstepA; const char* cB = (const char*)g.Bt + (size_t)cur.pn * tstepB;
    PG8_STAGE(PG8_SB(0, 0), cB, voffB); PG8_STAGE(PG8_SB(0, 1), cB + hstepB, voffB); PG8_STAGE(PG8_SA(0, 0), cA, voffA); PG8_STAGE(PG8_SA(0, 1), cA + hstepA, voffA);
    if (wr == 1) PG8_BAR;
    PG8_WAIT_V(2); PG8_BAR;
    PG8_STAGE(PG8_SB(1, 0), cB + kstep, voffB); PG8_STAGE(PG8_SA(1, 0), cA + kstep, voffA); PG8_STAGE(PG8_SB(1, 1), cB + hstepB + kstep, voffB);
    PG8_WAIT_V(6); PG8_BAR;
    for (;;) {
        const bool has_next = S.next(ui + 1, nxt);
        const char* nA = has_next ? (const char*)g.A + (size_t)nxt.pm * tstepA : cA; const char* nB = has_next ? (const char*)g.Bt + (size_t)nxt.pn * tstepB : cB;
        for (int t = 0; t < nt; t += 2) {
            const bool last = (t == nt - 2);
            const char* a1 = cA + (size_t)(t + 1) * kstep;
            const char* a2 = last ? nA : cA + (size_t)(t + 2) * kstep; const char* b2 = last ? nB : cB + (size_t)(t + 2) * kstep;
            const char* a3 = a2 + kstep; const char* b3 = b2 + kstep;
            PG8_LDB(B0, 0, 0); PG8_LDB(B1, 0, 1); PG8_SCHED; PG8_LDA(At, 0, 0); PG8_STAGE(PG8_SA(1, 1), a1 + hstepA, voffA);
            PG8_WAIT_V(8); PG8_WAIT_L(0); PG8_BAR; PG8_MMA(0, 0, At, B0); PG8_MMA(0, 1, At, B1); PG8_BAR; PG8_SCHED;
            PG8_LDA(At, 0, 1); PG8_STAGE(PG8_SB(0, 0), b2, voffB); PG8_STAGE(PG8_SB(0, 1), b2 + hstepB, voffB); PG8_STAGE(PG8_SA(0, 0), a2, voffA);
            PG8_WAIT_V(8); PG8_WAIT_L(0); PG8_BAR; PG8_MMA(1, 0, At, B0); PG8_MMA(1, 1, At, B1); PG8_BAR; PG8_SCHED;
            PG8_LDB(B0, 1, 0); PG8_LDB(B1, 1, 1); PG8_SCHED; PG8_LDA(At, 1, 0); PG8_STAGE(PG8_SA(0, 1), a2 + hstepA, voffA);
            PG8_WAIT_V(8); PG8_WAIT_L(0); PG8_BAR; PG8_MMA(0, 0, At, B0); PG8_MMA(0, 1, At, B1); PG8_BAR; PG8_SCHED;
            PG8_LDA(At, 1, 1); PG8_STAGE(PG8_SB(1, 0), b3, voffB); PG8_STAGE(PG8_SB(1, 1), b3 + hstepB, voffB); PG8_STAGE(PG8_SA(1, 0), a3, voffA);
            PG8_WAIT_V(8); PG8_WAIT_L(0); PG8_BAR; PG8_MMA(1, 0, At, B0); PG8_MMA(1, 1, At, B1); PG8_BAR; PG8_SCHED;
        }
        if constexpr (ALIGN_EPI) { if (wr == 0) PG8_BAR; }
        { int fr_ = fr, fq_ = fq; asm volatile("" : "+v"(fr_), "+v"(fq_)); E(acc, cur, wr, wc, fr_, fq_); }
        if (!has_next) break;
#pragma unroll
        for (int a = 0; a < 2; ++a)
#pragma unroll
            for (int b = 0; b < 2; ++b)
#pragma unroll
                for (int m = 0; m < 4; ++m)
#pragma unroll
                    for (int n = 0; n < 2; ++n) acc[a][b][m][n] = (f32x4){0.f, 0.f, 0.f, 0.f};
        cur = nxt; cA = nA; cB = nB; ++ui;
        if constexpr (ALIGN_EPI) { if (wr == 1) PG8_BAR; }
    }
    PG8_WAIT_V(0);
    if constexpr (!ALIGN_EPI) { if (wr == 0) PG8_BAR; }
    PG8_BAR;
#undef PG8_SA
#undef PG8_SB
#undef PG8_STAGE
#undef PG8_LDA
#undef PG8_LDB
#undef PG8_MMA
#undef PG8_WAIT_V
#undef PG8_WAIT_L
#undef PG8_BAR
#undef PG8_SCHED
}

typedef f32x4 Acc[2][2][4][2];

struct EpiStoreBf16 { static constexpr bool PERM = true; bf16_t* O; int ldc;
    __device__ __forceinline__ void operator()(const Acc& acc, const Unit& u, int wr, int wc, int fr, int fq) const {
        const int row0 = u.pm * BM + wr * 64 + fr, col0 = u.pn * BM + wc * 32 + 8 * fq;
#pragma unroll
        for (int ai = 0; ai < 2; ++ai)
#pragma unroll
            for (int m = 0; m < 4; ++m) { bf16_t* rowp = O + (size_t)(row0 + ai * HALF + m * 16) * ldc + col0;
#pragma unroll
                for (int bj = 0; bj < 2; ++bj) *(GAS u32x4*)(rowp + bj * HALF) = pack8(acc[ai][bj][m][0], acc[ai][bj][m][1]); }
    }
};
__device__ __forceinline__ void rstd8_from_ssp(const float* ssp, int row0, int fq, float (&rs)[2][4]) {
    f32x4 p[2][4];
#pragma unroll
    for (int ai = 0; ai < 2; ++ai)
#pragma unroll
        for (int m = 0; m < 4; ++m) p[ai][m] = *(const GAS f32x4*)(ssp + (size_t)(row0 + ai * 128 + m * 16) * 16 + 4 * fq);
#pragma unroll
    for (int ai = 0; ai < 2; ++ai)
#pragma unroll
        for (int m = 0; m < 4; ++m) { float v = (p[ai][m][0] + p[ai][m][1]) + (p[ai][m][2] + p[ai][m][3]); v += __shfl_xor(v, 16); v += __shfl_xor(v, 32); rs[ai][m] = rsqrtf(v * (1.0f / DM) + EPS); }
}
struct EpiSwiGLU { static constexpr bool PERM = true; bf16_t* O; const float* ssp; const float* shw;
    __device__ __forceinline__ void operator()(const Acc& acc, const Unit& u, int wr, int wc, int fr, int fq) const {
        const int row0 = u.pm * BM + wr * 64 + fr, col0 = u.pn * HALF + wc * 32 + 8 * fq, b = u.pm >> 5;
        f32x4 sg[2], su[2];
#pragma unroll
        for (int n = 0; n < 2; ++n) { sg[n] = *(const GAS f32x4*)(shw + (size_t)b * (2 * FF) + col0 + 4 * n); su[n] = *(const GAS f32x4*)(shw + (size_t)b * (2 * FF) + FF + col0 + 4 * n); }
        float rs8[2][4]; rstd8_from_ssp(ssp, row0, fq, rs8);
#pragma unroll
        for (int ai = 0; ai < 2; ++ai)
#pragma unroll
            for (int m = 0; m < 4; ++m) { const int row = row0 + ai * HALF + m * 16; const float rs = rs8[ai][m];
                bf16_t* rowp = O + (size_t)row * FF + col0;
                f32x4 o[2];
#pragma unroll
                for (int n = 0; n < 2; ++n)
#pragma unroll
                    for (int e = 0; e < 4; ++e) { const float gg = acc[ai][0][m][n][e] * rs + sg[n][e], uu = acc[ai][1][m][n][e] * rs + su[n][e]; o[n][e] = gg * fast_sigmoid(gg) * uu; }
                *(GAS u32x4*)rowp = pack8(o[0], o[1]);
                asm volatile("" ::: "memory"); }
    }
};
struct EpiProj { static constexpr bool PERM = true; bf16_t* O; const float* ssp; const float* shw;
    __device__ __forceinline__ void operator()(const Acc& acc, const Unit& u, int wr, int wc, int fr, int fq) const {
        const int row0 = u.pm * BM + wr * 64 + fr, col0 = u.pn * BM + wc * 32 + 8 * fq, b = u.pm >> 5;
        float rs8[2][4]; rstd8_from_ssp(ssp, row0, fq, rs8);
#pragma unroll
        for (int ai = 0; ai < 2; ++ai)
#pragma unroll
            for (int m = 0; m < 4; ++m) { const int row = row0 + ai * HALF + m * 16; const float rs = rs8[ai][m];
                bf16_t* rowp = O + (size_t)row * PROJ_LD + col0;
#pragma unroll
                for (int bj = 0; bj < 2; ++bj) { const f32x4 h0 = *(const GAS f32x4*)(shw + (size_t)b * PROJ_LD + col0 + bj * HALF), h1 = *(const GAS f32x4*)(shw + (size_t)b * PROJ_LD + col0 + bj * HALF + 4);
                    *(GAS u32x4*)(rowp + bj * HALF) = pack8(acc[ai][bj][m][0] * rs + h0, acc[ai][bj][m][1] * rs + h1); }
                asm volatile("" ::: "memory"); }
    }
};
template <int MODE> struct EpiResidN { static constexpr bool PERM = true; const void* base; void* xout; bf16_t* xa; float* ssp; const float* gate; const float* avec; float s;
    __device__ __forceinline__ void operator()(const Acc& acc, const Unit& u, int wr, int wc, int fr, int fq) const {
        const int row0 = u.pm * BM + wr * 64 + fr, col0 = u.pn * BM + wc * 32 + 8 * fq, b = u.pm >> 5;
        float ss[2][4];
#pragma unroll
        for (int ai = 0; ai < 2; ++ai)
#pragma unroll
            for (int m = 0; m < 4; ++m) ss[ai][m] = 0.f;
#pragma unroll
        for (int bj = 0; bj < 2; ++bj) { const int c = col0 + bj * HALF;
            const f32x4 g0 = *(const GAS f32x4*)(gate + (size_t)b * MODLD + c) * s, g1 = *(const GAS f32x4*)(gate + (size_t)b * MODLD + c + 4) * s;
            f32x4 a0 = {0.f, 0.f, 0.f, 0.f}, a1 = {0.f, 0.f, 0.f, 0.f};
            if (MODE < 2) { a0 = *(const GAS f32x4*)(avec + (size_t)b * DM + c); a1 = *(const GAS f32x4*)(avec + (size_t)b * DM + c + 4); }
            constexpr int NB = MODE == 0 ? 2 : 4;
#pragma unroll
            for (int r0 = 0; r0 < 8; r0 += NB) {
                f32x4 bf[NB][2]; u32x4 bw[NB];
#pragma unroll
                for (int q = 0; q < NB; ++q) { const int ai = (r0 + q) >> 2, m = (r0 + q) & 3; const size_t off = (size_t)(row0 + ai * HALF + m * 16) * DM + c;
                    if (MODE == 0) { bf[q][0] = *(const GAS f32x4*)((const float*)base + off); bf[q][1] = *(const GAS f32x4*)((const float*)base + off + 4); }
                    else bw[q] = *(const GAS u32x4*)((const bf16_t*)base + off); }
#pragma unroll
                for (int q = 0; q < NB; ++q) { const int ai = (r0 + q) >> 2, m = (r0 + q) & 3; const size_t off = (size_t)(row0 + ai * HALF + m * 16) * DM + c;
                    f32x4 b0, b1;
                    if (MODE == 0) { b0 = bf[q][0]; b1 = bf[q][1]; }
                    else { const u32x4 w = bw[q]; b0 = (f32x4){bf_lo(w.x), bf_hi(w.x), bf_lo(w.y), bf_hi(w.y)}; b1 = (f32x4){bf_lo(w.z), bf_hi(w.z), bf_lo(w.w), bf_hi(w.w)}; }
                    const f32x4 o0 = b0 + g0 * acc[ai][bj][m][0], o1 = b1 + g1 * acc[ai][bj][m][1];
                    if (MODE == 2) { *(GAS f32x4*)((float*)xout + off) = o0; *(GAS f32x4*)((float*)xout + off + 4) = o1; }
                    else { *(GAS u32x4*)((bf16_t*)xout + off) = pack8(o0, o1); *(GAS u32x4*)(xa + off) = pack8(o0 * a0, o1 * a1);
                        const f32x4 q0 = o0 * o0, q1 = o1 * o1; ss[ai][m] += ((q0[0] + q0[1]) + (q0[2] + q0[3])) + ((q1[0] + q1[1]) + (q1[2] + q1[3])); } }
                asm volatile("" ::: "memory");
            }
        }
        if (MODE < 2) {
#pragma unroll
            for (int ai = 0; ai < 2; ++ai)
#pragma unroll
                for (int m = 0; m < 4; ++m) { float v = ss[ai][m]; v += __shfl_xor(v, 16); v += __shfl_xor(v, 32);
                    if (fq == 0) ((GAS float*)ssp)[(size_t)(row0 + ai * HALF + m * 16) * 16 + u.pn * 4 + wc] = v; }
        }
    }
};
struct EpiVT { static constexpr bool PERM = true; bf16_t* O; const float* rstd;
    __device__ __forceinline__ void operator()(const Acc& acc, const Unit& u, int wr, int wc, int fr, int fq) const {
        const int row0 = u.pm * BM + wr * 64 + fr, col0 = u.pn * BM + wc * 32 + 8 * fq;
#pragma unroll
        for (int ai = 0; ai < 2; ++ai)
#pragma unroll
            for (int m = 0; m < 4; ++m) { bf16_t* rowp = O + (size_t)(row0 + ai * HALF + m * 16) * T + col0;
#pragma unroll
                for (int bj = 0; bj < 2; ++bj) *(GAS u32x4*)(rowp + bj * HALF) = pack8(acc[ai][bj][m][0], acc[ai][bj][m][1]); }
    }
};
template <int ROPE_TILE> struct EpiQK { static constexpr bool PERM = true; bf16_t* O; int ldo, hw; const float* rstd; const float* wn; const float* wrp; const float* cosT; const float* sinT; float c2;
    __device__ __forceinline__ void operator()(const Acc& acc, const Unit& u, int wr, int wc, int fr, int fq) const {
        const int row0 = u.pm * BM + wr * 64 + fr;
        const float* wn = this->wn; const float* wrp = this->wrp;
        asm volatile("" : "+s"(wn), "+s"(wrp));
        if (ROPE_TILE < 0 || u.pn != ROPE_TILE) {
            const int head = 4 * u.pn + wc;
#pragma unroll
            for (int ai = 0; ai < 2; ++ai)
#pragma unroll
                for (int m = 0; m < 4; ++m) { const int row = row0 + ai * HALF + m * 16; const float rs = 1.0f;
                    float ss = 0.f;
#pragma unroll
                    for (int bj = 0; bj < 2; ++bj)
#pragma unroll
                        for (int n = 0; n < 2; ++n) { const f32x4 q = acc[ai][bj][m][n] * acc[ai][bj][m][n]; ss += (q[0] + q[1]) + (q[2] + q[3]); }
                    ss += __shfl_xor(ss, 16); ss += __shfl_xor(ss, 32);
                    const float f = rs * rsqrtf(ss * rs * rs * (1.0f / 64.0f) + EPS) * c2;
                    bf16_t* rowp = O + (size_t)row * ldo + head * hw + 8 * fq;
#pragma unroll
                    for (int bj = 0; bj < 2; ++bj) { const f32x4 w0 = *(const GAS f32x4*)(wn + 32 * bj + 8 * fq), w1 = *(const GAS f32x4*)(wn + 32 * bj + 8 * fq + 4);
                        *(GAS u32x4*)(rowp + 32 * bj) = pack8(acc[ai][bj][m][0] * f * w0, acc[ai][bj][m][1] * f * w1); }
                    asm volatile("" ::: "memory"); }
        } else {
            const float sgn = (fq < 2) ? -1.0f : 1.0f;
#pragma unroll
            for (int ai = 0; ai < 2; ++ai)
#pragma unroll
                for (int m = 0; m < 4; ++m) { const int row = row0 + ai * HALF + m * 16; const float rs = 1.0f;
#pragma unroll
                    for (int bj = 0; bj < 2; ++bj) { float ss = 0.f;
#pragma unroll
                        for (int n = 0; n < 2; ++n) { const f32x4 q = acc[ai][bj][m][n] * acc[ai][bj][m][n]; ss += (q[0] + q[1]) + (q[2] + q[3]); }
                        ss += __shfl_xor(ss, 16); ss += __shfl_xor(ss, 32);
                        const float f = rs * rsqrtf(ss * rs * rs * (1.0f / 32.0f) + EPS);
#pragma unroll
                        for (int n = 0; n < 2; ++n) { const f32x4 w = *(const GAS f32x4*)(wrp + 8 * fq + 4 * n);
                            const f32x4 cs = *(const GAS f32x4*)(cosT + (size_t)row * 16 + 8 * (fq & 1) + 4 * n), sn = *(const GAS f32x4*)(sinT + (size_t)row * 16 + 8 * (fq & 1) + 4 * n);
                            f32x4 o;
#pragma unroll
                            for (int e = 0; e < 4; ++e) { const float y = acc[ai][bj][m][n][e] * f * w[e]; const float pt = __shfl_xor(y, 32); o[e] = (y * cs[e] + sgn * pt * sn[e]) * c2; }
                            *(GAS u32x2*)(O + (size_t)row * ldo + (4 * bj + wc) * hw + 64 + 8 * fq + 4 * n) = (u32x2){cvt_pk_bf16(o[0], o[1]), cvt_pk_bf16(o[2], o[3])}; } }
                    asm volatile("" ::: "memory"); }
        }
    }
};
template <bool FIRST> struct EpiBranch { static constexpr bool PERM = true; bf16_t* O; const bf16_t* GL;
    __device__ __forceinline__ void operator()(const Acc& acc, const Unit& u, int wr, int wc, int fr, int fq) const {
        const int row0 = u.pm * BM + wr * 64 + fr, col0 = u.pn * BM + wc * 32 + 8 * fq;
#pragma unroll
        for (int ai = 0; ai < 2; ++ai)
#pragma unroll
            for (int m = 0; m < 4; ++m) { const size_t row = (size_t)(row0 + ai * HALF + m * 16);
#pragma unroll
                for (int bj = 0; bj < 2; ++bj) { const int c = col0 + bj * HALF;
                    const u32x4 gw = *(const GAS u32x4*)(GL + row * PROJ_LD + c);
                    f32x4 g0 = {bf_lo(gw.x), bf_hi(gw.x), bf_lo(gw.y), bf_hi(gw.y)}, g1 = {bf_lo(gw.z), bf_hi(gw.z), bf_lo(gw.w), bf_hi(gw.w)};
                    f32x4 o0, o1;
#pragma unroll
                    for (int e = 0; e < 4; ++e) { o0[e] = fast_sigmoid(g0[e]) * acc[ai][bj][m][0][e]; o1[e] = fast_sigmoid(g1[e]) * acc[ai][bj][m][1][e]; }
                    bf16_t* op = O + row * DM + c;
                    if (!FIRST) { const u32x4 ow = *(const GAS u32x4*)op;
                        o0 += (f32x4){bf_lo(ow.x), bf_hi(ow.x), bf_lo(ow.y), bf_hi(ow.y)}; o1 += (f32x4){bf_lo(ow.z), bf_hi(ow.z), bf_lo(ow.w), bf_hi(ow.w)}; }
                    *(GAS u32x4*)op = pack8(o0, o1); } }
    }
};
}

namespace att {
constexpr int KROW = 208, VROW = 144, KBUF = 64 * KROW, VBUF = 64 * VROW, V_OFF = 4 * KBUF;
constexpr float THR = 8.0f;
#define ATT_SB() __builtin_amdgcn_sched_barrier(0)
#define ATT_E(i) ((i) < 16 ? e0[(i) & 15] : e1[(i) & 15])
__device__ __forceinline__ float rowmax32(const f32x16& a, const f32x16& b) {
    float x = fmaxf(fmaxf(a[0], a[1]), b[0]), y = fmaxf(fmaxf(a[2], a[3]), b[1]); x = fmaxf(fmaxf(x, b[2]), b[3]);
#pragma unroll
    for (int r = 4; r < 16; r += 4) { x = fmaxf(fmaxf(x, a[r]), a[r + 1]); y = fmaxf(fmaxf(y, a[r + 2]), a[r + 3]); x = fmaxf(fmaxf(x, b[r]), b[r + 1]); y = fmaxf(fmaxf(y, b[r + 2]), b[r + 3]); }
    return fmaxf(x, y);
}
__device__ __forceinline__ void cmask(f32x16& p0, f32x16& p1, int kv0, int qidx, int hi) {
#pragma unroll
    for (int r = 0; r < 16; ++r) { const int kv = kv0 + (r & 3) + 8 * (r >> 2) + 4 * hi; if (kv > qidx) p0[r] = -INFINITY; if (kv + 32 > qidx) p1[r] = -INFINITY; }
}
template <int P> __device__ __forceinline__ void tile_iter(LAS unsigned char* lds, const int jt, const int NT, const int jmax, const int q0, const int qidx, const int hi,
        const unsigned ka, const unsigned va, const bf16_t* kn_src, const bf16_t* kr_src, const bf16_t* vt_src, const unsigned kn_dst, const unsigned kr_dst, const unsigned vt_dst, const bool has_r,
        const bf16x8 (&qr)[6], f32x16& o0, f32x16& o1, f32x16& negm, f32x16& s0, f32x16& s1, f32x16& e0, f32x16& e1, float& m_run, float& l_run,
        u32x4 (&gK)[2], u32x4 (&gR)[2], u32x4 (&gV)[2]) {
        { const unsigned nk = ((jt + 3) & 3) * KBUF, nv = ((jt + 2) & 3) * VBUF;
          *(LAS u32x4*)(lds + nk + kn_dst) = gK[P]; *(LAS u32x4*)(lds + nk + kr_dst) = gR[P];
          *(LAS u32x2*)(lds + nv + vt_dst) = (u32x2){gV[P].x, gV[P].y}; *(LAS u32x2*)(lds + nv + vt_dst + 16) = (u32x2){gV[P].z, gV[P].w};
          const int tk = (jt + 5 < NT) ? jt + 5 : NT - 1, tv = (jt + 4 < NT) ? jt + 4 : NT - 1;
          gK[P] = *(const GAS u32x4*)(kn_src + (size_t)tk * 64 * 512); gR[P] = *(const GAS u32x4*)(kr_src + (size_t)tk * 64 * 32); gV[P] = *(const GAS u32x4*)(vt_src + (size_t)tv * 64); }
        if (jt <= jmax) {
            const bool nx = jt + 1 <= jmax;
            const unsigned kb = ((jt + 1) & 3) * KBUF + ka, vb = (jt & 3) * VBUF + va;
            u32x4 pf[4]; float sacc = 0.f;
            {
                bf16x8 kf0 = *(const LAS bf16x8*)(lds + kb), kf1 = *(const LAS bf16x8*)(lds + kb + 32 * KROW), kn0 = kf0, kn1 = kf1;
                __builtin_amdgcn_s_setprio(1);
#pragma unroll
                for (int ks = 0; ks < 6; ++ks) {
                    if (ks < 5) { kn0 = *(const LAS bf16x8*)(lds + kb + (ks + 1) * 32); kn1 = *(const LAS bf16x8*)(lds + kb + 32 * KROW + (ks + 1) * 32); }
                    s0 = __builtin_amdgcn_mfma_f32_32x32x16_bf16(kf0, qr[ks], ks == 0 ? negm : s0, 0, 0, 0);
#pragma unroll
                    for (int i = (16 * ks) / 3; i < (16 * ks + 8) / 3; ++i) sacc += ATT_E(i);
#pragma unroll
                    for (int c = (8 * ks) / 3; c < (8 * ks + 4) / 3; ++c) pf[c >> 2][c & 3] = cvt_pk_bf16(ATT_E(2 * c), ATT_E(2 * c + 1));
                    ATT_SB();
                    s1 = __builtin_amdgcn_mfma_f32_32x32x16_bf16(kf1, qr[ks], ks == 0 ? negm : s1, 0, 0, 0);
#pragma unroll
                    for (int i = (16 * ks + 8) / 3; i < (16 * ks + 16) / 3; ++i) sacc += ATT_E(i);
#pragma unroll
                    for (int c = (8 * ks + 4) / 3; c < (8 * ks + 8) / 3; ++c) pf[c >> 2][c & 3] = cvt_pk_bf16(ATT_E(2 * c), ATT_E(2 * c + 1));
                    ATT_SB();
                    kf0 = kn0; kf1 = kn1;
                }
                __builtin_amdgcn_s_setprio(0);
            }
            l_run += sacc;
            float fsc = 1.0f; bool resc = false;
            if (nx) {
                const int kv0 = (jt + 1) * 64;
                if (kv0 + 63 > q0) cmask(s0, s1, kv0, qidx, hi);
                float rm = rowmax32(s0, s1);
                if (__any(rm > THR)) {
                    rm = fmaxf(rm, __shfl_xor(rm, 32));
                    const float dl = fmaxf(rm, 0.f);
                    m_run += dl; fsc = __builtin_amdgcn_exp2f(-dl); l_run *= fsc; resc = true;
#pragma unroll
                    for (int r = 0; r < 16; ++r) { s0[r] -= dl; s1[r] -= dl; negm[r] = -m_run; }
                }
            }
            ATT_SB();
            {
#define ATT_VA(m) (vb + ((m) & 1) * 32 * VROW + ((m) >> 1) * 32)
                bf16x8 vq[3];
                vq[0] = *(const LAS bf16x8*)(lds + ATT_VA(0)); vq[1] = *(const LAS bf16x8*)(lds + ATT_VA(1));
                __builtin_amdgcn_s_setprio(1);
#pragma unroll
                for (int m = 0; m < 8; ++m) {
                    if (m < 6) vq[(m + 2) % 3] = *(const LAS bf16x8*)(lds + ATT_VA(m + 2));
                    const bf16x8 vf = vq[m % 3];
                    const bf16x8 pb = __builtin_bit_cast(bf16x8, pf[m >> 1]);
                    if ((m & 1) == 0) o0 = __builtin_amdgcn_mfma_f32_32x32x16_bf16(vf, pb, o0, 0, 0, 0);
                    else o1 = __builtin_amdgcn_mfma_f32_32x32x16_bf16(vf, pb, o1, 0, 0, 0);
                    if (m < 4) {
#pragma unroll
                        for (int i = 4 * m; i < 4 * m + 4; ++i) e0[i] = __builtin_amdgcn_exp2f(s0[i]);
                        asm volatile("" : "+v"(e0));
                    } else {
#pragma unroll
                        for (int i = 4 * m - 16; i < 4 * m - 12; ++i) e1[i] = __builtin_amdgcn_exp2f(s1[i]);
                        asm volatile("" : "+v"(e1));
                    }
                    ATT_SB();
                }
                __builtin_amdgcn_s_setprio(0);
#undef ATT_VA
            }
            if (resc) {
#pragma unroll
                for (int r = 0; r < 16; ++r) { o0[r] *= fsc; o1[r] *= fsc; }
            }
        }
        if (P == 1) __syncthreads();
}
__device__ __forceinline__ void unit(LAS unsigned char* lds, int b, int h, int qb, const bf16_t* Q, const bf16_t* KN, const bf16_t* KR, const bf16_t* VT, bf16_t* O) {
    const int tid = opq_tid(), lane = tid & 63, wid = __builtin_amdgcn_readfirstlane(tid >> 6), r32 = lane & 31, hi = lane >> 5;
    const size_t tok0 = (size_t)b * SEQ;
    const int q0 = qb * 256 + wid * 32, qidx = q0 + r32, NT = 4 * (qb + 1), jmax = (q0 + 31) >> 6;
    bf16x8 qr[6];
    { const bf16_t* qp = Q + (tok0 + qidx) * QLD + h * 96 + hi * 8;
#pragma unroll
      for (int ks = 0; ks < 6; ++ks) qr[ks] = *(const GAS bf16x8*)(qp + ks * 16); }
    const int krow = tid >> 3, kch = tid & 7, rrow = (tid >> 2) & 63, rch = tid & 3;
    const bf16_t* kn_src = KN + (tok0 + krow) * 512 + h * 64 + kch * 8;
    const bf16_t* kr_src = KR + (tok0 + rrow) * 32 + rch * 8;
    const bf16_t* vt_src = VT + (size_t)(h * 64 + krow) * T + tok0 + kch * 8;
    const unsigned kn_dst = krow * KROW + kch * 16, kr_dst = rrow * KROW + 128 + rch * 16, vt_dst = V_OFF + krow * VROW + (kch >> 1) * 32 + (kch & 1) * 8;
    const bool has_r = tid < 256;
    u32x4 gk, gr = {0u, 0u, 0u, 0u}, gv;
    u32x4 gK[2], gR[2], gV[2];
    gK[0] = gr; gK[1] = gr; gR[0] = gr; gR[1] = gr; gV[0] = gr; gV[1] = gr;
    {
        gk = *(const GAS u32x4*)kn_src; gr = *(const GAS u32x4*)kr_src; gv = *(const GAS u32x4*)vt_src;
        const u32x4 gk1 = *(const GAS u32x4*)(kn_src + (size_t)64 * 512), gr1 = *(const GAS u32x4*)(kr_src + (size_t)64 * 32), gv1 = *(const GAS u32x4*)(vt_src + 64);
        const u32x4 gk2 = *(const GAS u32x4*)(kn_src + (size_t)2 * 64 * 512), gr2 = *(const GAS u32x4*)(kr_src + (size_t)2 * 64 * 32);
        gK[0] = *(const GAS u32x4*)(kn_src + (size_t)3 * 64 * 512); gR[0] = *(const GAS u32x4*)(kr_src + (size_t)3 * 64 * 32); gV[0] = *(const GAS u32x4*)(vt_src + (size_t)2 * 64);
        { const int t4 = NT > 4 ? 4 : 3; gK[1] = *(const GAS u32x4*)(kn_src + (size_t)t4 * 64 * 512); gR[1] = *(const GAS u32x4*)(kr_src + (size_t)t4 * 64 * 32); gV[1] = *(const GAS u32x4*)(vt_src + (size_t)3 * 64); }
        *(LAS u32x4*)(lds + kn_dst) = gk; *(LAS u32x4*)(lds + kr_dst) = gr;
        *(LAS u32x2*)(lds + vt_dst) = (u32x2){gv.x, gv.y}; *(LAS u32x2*)(lds + vt_dst + 16) = (u32x2){gv.z, gv.w};
        *(LAS u32x4*)(lds + KBUF + kn_dst) = gk1; *(LAS u32x4*)(lds + KBUF + kr_dst) = gr1;
        *(LAS u32x2*)(lds + VBUF + vt_dst) = (u32x2){gv1.x, gv1.y}; *(LAS u32x2*)(lds + VBUF + vt_dst + 16) = (u32x2){gv1.z, gv1.w};
        *(LAS u32x4*)(lds + 2 * KBUF + kn_dst) = gk2; *(LAS u32x4*)(lds + 2 * KBUF + kr_dst) = gr2;
    }
    __syncthreads();
    const unsigned ka = r32 * KROW + hi * 16;
    const unsigned va = V_OFF + r32 * VROW + hi * 16;
    f32x16 o0, o1, negm, s0, s1, e0, e1;
#pragma unroll
    for (int r = 0; r < 16; ++r) { o0[r] = 0.f; o1[r] = 0.f; s0[r] = 0.f; s1[r] = 0.f; }
    float m_run, l_run = 0.f;
    {
#pragma unroll
        for (int ks = 0; ks < 6; ++ks) {
            const bf16x8 k0 = *(const LAS bf16x8*)(lds + ka + ks * 32), k1 = *(const LAS bf16x8*)(lds + ka + 32 * KROW + ks * 32);
            s0 = __builtin_amdgcn_mfma_f32_32x32x16_bf16(k0, qr[ks], s0, 0, 0, 0);
            s1 = __builtin_amdgcn_mfma_f32_32x32x16_bf16(k1, qr[ks], s1, 0, 0, 0);
        }
        if (63 > q0) cmask(s0, s1, 0, qidx, hi);
        float rm = rowmax32(s0, s1); rm = fmaxf(rm, __shfl_xor(rm, 32));
        m_run = rm;
#pragma unroll
        for (int r = 0; r < 16; ++r) { e0[r] = __builtin_amdgcn_exp2f(s0[r] - rm); e1[r] = __builtin_amdgcn_exp2f(s1[r] - rm); negm[r] = -rm; }
    }
    __syncthreads();
    for (int jt = 0; jt < NT; jt += 2) {
        tile_iter<0>(lds, jt, NT, jmax, q0, qidx, hi, ka, va, kn_src, kr_src, vt_src, kn_dst, kr_dst, vt_dst, has_r, qr, o0, o1, negm, s0, s1, e0, e1, m_run, l_run, gK, gR, gV);
        tile_iter<1>(lds, jt + 1, NT, jmax, q0, qidx, hi, ka, va, kn_src, kr_src, vt_src, kn_dst, kr_dst, vt_dst, has_r, qr, o0, o1, negm, s0, s1, e0, e1, m_run, l_run, gK, gR, gV);
    }
    const float lt = l_run + __shfl_xor(l_run, 32);
    const float inv = 1.0f / lt;
    bf16_t* op = O + (tok0 + qidx) * 512 + h * 64 + 4 * hi;
#pragma unroll
    for (int g = 0; g < 4; ++g) {
        *(GAS u32x2*)(op + 8 * g) = (u32x2){cvt_pk_bf16(o0[4 * g] * inv, o0[4 * g + 1] * inv), cvt_pk_bf16(o0[4 * g + 2] * inv, o0[4 * g + 3] * inv)};
        *(GAS u32x2*)(op + 32 + 8 * g) = (u32x2){cvt_pk_bf16(o1[4 * g] * inv, o1[4 * g + 1] * inv), cvt_pk_bf16(o1[4 * g + 2] * inv, o1[4 * g + 3] * inv)};
    }
}
__device__ __forceinline__ void phase(LAS unsigned char* lds, const bf16_t* Q, const bf16_t* KN, const bf16_t* KR, const bf16_t* VT, bf16_t* O) {
    for (int j = blockIdx.x; j < 2048; j += gridDim.x) {
        const int bh = j & 63, qslot = j >> 6, k = qslot >> 2, s = qslot & 3, i = k >> 1;
        const int qb = (k & 1) ? 31 - (4 * i + s) : 4 * i + s;
        unit(lds, bh >> 3, bh & 7, qb, Q, KN, KR, VT, O);
    }
}
#undef ATT_SB
#undef ATT_E
}

__device__ __forceinline__ int src_col(int map, int n0) {
    const int pn = n0 >> 8, bj = (n0 >> 7) & 1, wc = (n0 >> 5) & 3;
    switch (map) {
        case 1: return bj * FF + 128 * pn + (n0 & 127);
        case 2: return pn < 2 ? 96 * (4 * pn + wc) + 32 * bj : 96 * (4 * bj + wc) + 64;
        case 3: return 128 * (4 * pn + wc) + 32 * bj;
        case 4: return 128 * (n0 >> 6) + 64 + (n0 & 63);
        case 5: return n0 < 4000 ? n0 : -1;
        default: return n0;
    }
}
__device__ __forceinline__ void tr_item(const float* W, int K, int pitch, bf16_t* WT, const float* scale, int map, int nblk, LAS float* scr, int item, int lane) {
    const int kb = item / nblk, nb = item % nblk, k0 = 64 * kb, n0 = 32 * nb;
    const int sc0 = src_col(map, n0);
#pragma unroll 8
    for (int i = 0; i < 32; ++i) { const int kk = 2 * i + (lane >> 5); float v = 0.f;
        if (sc0 >= 0) { v = ((const GAS float*)W)[(size_t)(k0 + kk) * pitch + sc0 + (lane & 31)]; if (scale) v *= ((const GAS float*)scale)[k0 + kk]; }
        scr[kk * 33 + (lane & 31)] = v; }
    asm volatile("s_waitcnt lgkmcnt(0)" ::: "memory");
    const int c = lane & 7;
#pragma unroll
    for (int j = 0; j < 4; ++j) { const int n = (lane >> 3) + 8 * j; const LAS float* s = scr + (8 * c) * 33 + n;
        u32x4 o; o.x = cvt_pk_bf16(s[0 * 33], s[1 * 33]); o.y = cvt_pk_bf16(s[2 * 33], s[3 * 33]); o.z = cvt_pk_bf16(s[4 * 33], s[5 * 33]); o.w = cvt_pk_bf16(s[6 * 33], s[7 * 33]);
        *(GAS u32x4*)(WT + (size_t)(n0 + n) * K + k0 + 8 * c) = o; }
    asm volatile("s_waitcnt lgkmcnt(0)" ::: "memory");
}

struct Args { const void* in[20]; float* out; unsigned char* ws; int ph_lo, ph_hi; };

__device__ __forceinline__ void gemv64(const LAS float* sc, LAS float* red, const float* W, int pitch, int n0, int nvalid, const float* bias, float* out, int ldo, int tid) {
    const int lane = tid & 63, wid = tid >> 6, n = n0 + lane; const bool valid = n < nvalid;
    const GAS float* Wg = (const GAS float*)W + (valid ? n : 0);
    float acc[8];
#pragma unroll
    for (int b = 0; b < 8; ++b) acc[b] = 0.f;
#pragma unroll 16
    for (int kk = 0; kk < 128; ++kk) { const int k = wid * 128 + kk; const float w = Wg[(size_t)k * pitch];
#pragma unroll
        for (int b = 0; b < 8; ++b) acc[b] += sc[b * 1024 + k] * w; }
#pragma unroll
    for (int b = 0; b < 8; ++b) red[(wid * 8 + b) * 64 + lane] = acc[b];
    __syncthreads();
    { float sum = (bias && valid) ? ((const GAS float*)bias)[n] : 0.f;
#pragma unroll
      for (int w = 0; w < 8; ++w) sum += red[(w * 8 + wid) * 64 + lane];
      ((GAS float*)out)[(size_t)wid * ldo + n] = valid ? sum : 0.f; }
    __syncthreads();
}
__device__ __forceinline__ void xa_phase(const Args& A, LAS unsigned char* lds) {
    const int tid = opq_tid(), lane = tid & 63, wid = tid >> 6;
    unsigned char* ws = opq(A.ws);
    const float* mod = (const float*)(ws + WS_MOD);
    const float* normw = (const float*)A.in[5];
    {
        LAS float* sc = (LAS float*)lds; LAS float* red = (LAS float*)(lds + 32768);
        for (int it = blockIdx.x; it < 240; it += gridDim.x) {
            int sub, g; const float* W; int pitch, nvalid, ldo; float* out;
            if (it < 88) { sub = 0; g = it; W = (const float*)A.in[6]; pitch = 2 * FF; nvalid = 2 * FF; ldo = 2 * FF; out = (float*)(ws + WS_SHW0); }
            else if (it < 152) { sub = 1; g = it - 88; W = (const float*)A.in[8]; pitch = 4000; nvalid = 4000; ldo = PROJ_LD; out = (float*)(ws + WS_SHW1); }
            else { sub = 2; g = it - 152; W = (const float*)A.in[6] + (size_t)DM * 2 * FF; pitch = 2 * FF; nvalid = 2 * FF; ldo = 2 * FF; out = (float*)(ws + WS_SHW2); }
            for (int i = tid; i < 8192; i += 512) sc[i] = ((const GAS float*)mod)[(size_t)(i >> 10) * MODLD + sub * 3072 + (i & 1023)];
            __syncthreads();
            gemv64(sc, red, W, pitch, g * 64, nvalid, nullptr, out, ldo, tid);
        }
        if ((int)blockIdx.x == (int)gridDim.x - 1) {
            float* av = (float*)(ws + WS_AVEC);
            for (int i = tid; i < 2 * 8 * 1024; i += 512) { const int sb = i >> 13, b = (i >> 10) & 7, c = i & 1023;
                ((GAS float*)av)[i] = ((const GAS float*)normw)[(sb + 1) * 1024 + c] * (1.0f + ((const GAS float*)mod)[(size_t)b * MODLD + (sb + 1) * 3072 + 1024 + c]); }
        }
    }
    const float* X = (const float*)A.in[0]; bf16_t* XA = (bf16_t*)(ws + WS_H); float* ssp = (float*)(ws + WS_SSP);
    const int gw = blockIdx.x * 8 + wid, NGW = gridDim.x * 8;
    for (int ch = gw; ch < T / 32; ch += NGW) {
        const int row0 = ch * 32, b = row0 / SEQ;
        const float* scp = mod + (size_t)b * MODLD + 1024;
        f32x4 a[4];
#pragma unroll
        for (int j = 0; j < 4; ++j) { const int c = 4 * lane + 256 * j; a[j] = *(const GAS f32x4*)(normw + c) * (*(const GAS f32x4*)(scp + c) + 1.0f); }
        f32x4 vn[4];
        { const float* xr = X + (size_t)row0 * DM + 4 * lane;
#pragma unroll
          for (int j = 0; j < 4; ++j) vn[j] = *(const GAS f32x4*)(xr + 256 * j); }
        for (int r = 0; r < 32; ++r) {
            f32x4 v[4]; float ss = 0.f;
#pragma unroll
            for (int j = 0; j < 4; ++j) v[j] = vn[j];
            if (r < 31) { const float* xr = X + (size_t)(row0 + r + 1) * DM + 4 * lane;
#pragma unroll
                for (int j = 0; j < 4; ++j) vn[j] = *(const GAS f32x4*)(xr + 256 * j); }
#pragma unroll
            for (int j = 0; j < 4; ++j) { const f32x4 q = v[j] * v[j]; ss += (q[0] + q[1]) + (q[2] + q[3]); }
            ss = wave_sum(ss);
            bf16_t* hr = XA + (size_t)(row0 + r) * DM + 4 * lane;
#pragma unroll
            for (int j = 0; j < 4; ++j) { const f32x4 o = v[j] * a[j]; *(GAS u32x2*)(hr + 256 * j) = (u32x2){cvt_pk_bf16(o[0], o[1]), cvt_pk_bf16(o[2], o[3])}; }
            if (lane < 16) ((GAS float*)ssp)[(size_t)(row0 + r) * 16 + lane] = lane == 0 ? ss : 0.f;
        }
    }
}

__device__ __forceinline__ void unpack8(const u32x4 w, float (&f)[8]) { f[0] = bf_lo(w.x); f[1] = bf_hi(w.x); f[2] = bf_lo(w.y); f[3] = bf_hi(w.y); f[4] = bf_lo(w.z); f[5] = bf_hi(w.z); f[6] = bf_lo(w.w); f[7] = bf_hi(w.w); }

__device__ __forceinline__ void conv_phase(const bf16_t* P, const float* convw, const float* krw, const float* cosT, const float* sinT, float* rstdq, float* rstdkv, bf16_t* KR, bf16_t* OC) {
    const int tid = opq_tid(), lane = tid & 63, gw = blockIdx.x * 8 + (tid >> 6), NGW = gridDim.x * 8;
    float w0[8], w1[8], w2[8];
#pragma unroll
    for (int e = 0; e < 8; ++e) { w0[e] = convw[8 * lane + e]; w1[e] = convw[512 + 8 * lane + e]; w2[e] = convw[1024 + 8 * lane + e]; }
    const int kl = (lane - 48) & 3;
    float kw[8];
#pragma unroll
    for (int e = 0; e < 8; ++e) kw[e] = krw[8 * kl + e];
    for (int ch = gw; ch < T / 32; ch += NGW) {
        const int row0 = ch * 32, s0 = row0 % SEQ;
        float um2[8], um1[8];
#pragma unroll
        for (int e = 0; e < 8; ++e) { um2[e] = 0.f; um1[e] = 0.f; }
        if (s0 > 0) {
            float a[8], c[8];
            unpack8(*(const GAS u32x4*)(P + (size_t)(row0 - 2) * PROJ_LD + C_CONV + 8 * lane), a); unpack8(*(const GAS u32x4*)(P + (size_t)(row0 - 2) * PROJ_LD + C_GC + 8 * lane), c);
#pragma unroll
            for (int e = 0; e < 8; ++e) um2[e] = a[e] * c[e];
            unpack8(*(const GAS u32x4*)(P + (size_t)(row0 - 1) * PROJ_LD + C_CONV + 8 * lane), a); unpack8(*(const GAS u32x4*)(P + (size_t)(row0 - 1) * PROJ_LD + C_GC + 8 * lane), c);
#pragma unroll
            for (int e = 0; e < 8; ++e) um1[e] = a[e] * c[e];
        }
        u32x4 nxv, ngb, ngc, nst = {0u, 0u, 0u, 0u};
        { const bf16_t* pr = P + (size_t)row0 * PROJ_LD;
          nxv = *(const GAS u32x4*)(pr + C_CONV + 8 * lane); ngb = *(const GAS u32x4*)(pr + C_GB + 8 * lane); ngc = *(const GAS u32x4*)(pr + C_GC + 8 * lane);
          if (lane < 52) nst = *(const GAS u32x4*)(pr + 8 * lane); }
        for (int r = 0; r < 32; ++r) {
            const size_t row = (size_t)(row0 + r);
            float xv[8], gb[8], gc[8], st[8];
            unpack8(nxv, xv); unpack8(ngb, gb); unpack8(ngc, gc); unpack8(nst, st);
            if (r < 31) { const bf16_t* pr = P + (row + 1) * PROJ_LD;
                nxv = *(const GAS u32x4*)(pr + C_CONV + 8 * lane); ngb = *(const GAS u32x4*)(pr + C_GB + 8 * lane); ngc = *(const GAS u32x4*)(pr + C_GC + 8 * lane);
                if (lane < 52) nst = *(const GAS u32x4*)(pr + 8 * lane); }
            float o[8];
#pragma unroll
            for (int e = 0; e < 8; ++e) { const float u = gc[e] * xv[e]; o[e] = gb[e] * (w0[e] * um2[e] + w1[e] * um1[e] + w2[e] * u); um2[e] = um1[e]; um1[e] = u; }
            *(GAS u32x4*)(OC + row * 512 + 8 * lane) = (u32x4){cvt_pk_bf16(o[0], o[1]), cvt_pk_bf16(o[2], o[3]), cvt_pk_bf16(o[4], o[5]), cvt_pk_bf16(o[6], o[7])};
            float ss = 0.f;
#pragma unroll
            for (int e = 0; e < 8; ++e) ss += st[e] * st[e];
            const float sq = wave_sum(lane < 32 ? ss : 0.f), skv = wave_sum((lane >= 32 && lane < 48) ? ss : 0.f), skr = wave_sum((lane >= 48 && lane < 52) ? ss : 0.f);
            { const float rn = lane < 32 ? rsqrtf(sq * (1.0f / 256.0f) + EPS) : rsqrtf(skv * (1.0f / 128.0f) + EPS);
              if (lane < 48) *(GAS u32x4*)((bf16_t*)P + row * PROJ_LD + 8 * lane) = (u32x4){cvt_pk_bf16(st[0] * rn, st[1] * rn), cvt_pk_bf16(st[2] * rn, st[3] * rn), cvt_pk_bf16(st[4] * rn, st[5] * rn), cvt_pk_bf16(st[6] * rn, st[7] * rn)}; }
            const float rk = rsqrtf(skr * (1.0f / 32.0f) + EPS);
            const f32x4 c0 = *(const GAS f32x4*)(cosT + row * 16 + 8 * (kl & 1)), c1 = *(const GAS f32x4*)(cosT + row * 16 + 8 * (kl & 1) + 4);
            const f32x4 s0v = *(const GAS f32x4*)(sinT + row * 16 + 8 * (kl & 1)), s1v = *(const GAS f32x4*)(sinT + row * 16 + 8 * (kl & 1) + 4);
            const float sgn = (kl < 2) ? -1.0f : 1.0f;
            float ko[8];
#pragma unroll
            for (int e = 0; e < 8; ++e) { const float y = st[e] * rk * kw[e]; const float pt = __shfl_xor(y, 2);
                const float cc = e < 4 ? c0[e & 3] : c1[e & 3], sn = e < 4 ? s0v[e & 3] : s1v[e & 3]; ko[e] = y * cc + sgn * pt * sn; }
            if (lane >= 48 && lane < 52) *(GAS u32x4*)(KR + row * 32 + 8 * kl) = (u32x4){cvt_pk_bf16(ko[0], ko[1]), cvt_pk_bf16(ko[2], ko[3]), cvt_pk_bf16(ko[4], ko[5]), cvt_pk_bf16(ko[6], ko[7])};
        }
    }
}

__device__ const float INV_FREQ[16] = {1.0f, 0.5623413324356079f, 0.3162277638912201f, 0.17782793939113617f, 0.10000000149011612f, 0.05623412877321243f, 0.03162277862429619f, 0.017782794311642647f,
    0.009999999776482582f, 0.005623413249850273f, 0.003162277862429619f, 0.0017782794311642647f, 0.0010000000474974513f, 0.000562341301701963f, 0.0003162277862429619f, 0.00017782794020604342f};

__device__ __forceinline__ void sincos_reduced(float ang, float& s, float& c) {
    const double x = (double)ang;
    const double k = __builtin_rint(x * 0.15915494309189535);
    const float r = (float)(x - k * 6.283185307179586);
    s = __sinf(r); c = __cosf(r);
}

__device__ __forceinline__ void prologue(const Args& A, LAS unsigned char* lds) {
    const int tid = opq_tid(), lane = tid & 63, wid = tid >> 6;
    unsigned char* ws = opq(A.ws);
    {
        LAS float* sc = (LAS float*)lds; LAS float* red = (LAS float*)(lds + 32768);
        const float* c = (const float*)A.in[1];
        if ((int)blockIdx.x < 144) {
            for (int i = tid; i < 8192; i += 512) { const float v = ((const GAS float*)c)[i]; sc[i] = v / (1.0f + __expf(-v)); }
            __syncthreads();
        }
        for (int cgp = blockIdx.x; cgp < 144; cgp += gridDim.x)
            gemv64(sc, red, (const float*)A.in[3], MODLD, cgp * 64, MODLD, (const float*)A.in[4], (float*)(ws + WS_MOD), MODLD, tid);
    }
    __syncthreads();
    {
        const int* pos = (const int*)A.in[2]; float* cosT = (float*)(ws + WS_COS); float* sinT = (float*)(ws + WS_SIN);
        for (int idx = blockIdx.x * 512 + tid; idx < T * 16; idx += gridDim.x * 512) {
            const float ang = (float)((const GAS int*)pos)[idx >> 4] * INV_FREQ[idx & 15]; float s, c; sincos_reduced(ang, s, c); ((GAS float*)cosT)[idx] = c; ((GAS float*)sinT)[idx] = s; }
    }
    {
        LAS float* scr = (LAS float*)(lds + wid * 16384);
        const int gw = blockIdx.x * 8 + wid, NGW = gridDim.x * 8;
        const float* w13 = (const float*)A.in[6]; const float* w2 = (const float*)A.in[7]; const float* win = (const float*)A.in[8];
        const float* qan = (const float*)A.in[9]; const float* wuq = (const float*)A.in[10]; const float* kvan = (const float*)A.in[11]; const float* wukv = (const float*)A.in[12];
        const float* wbr = (const float*)A.in[18]; const float* wout = (const float*)A.in[19];
        constexpr int I13 = 16 * 176, I2 = 44 * 32, IIN = 16 * 128, IUQ = 4 * 24, IUK = 2 * 16, IV = 2 * 16, IB = 8 * 32, IO = 16 * 32;
        constexpr int NIT = 2 * I13 + 2 * I2 + IIN + IUQ + IUK + IV + 2 * IB + IO;
        for (int it = gw; it < NIT; it += NGW) {
            int r = it;
            if (r < I13) { tr_item(w13, 1024, 5632, (bf16_t*)(ws + WS_W13A), nullptr, 1, 176, scr, r, lane); continue; } r -= I13;
            if (r < I13) { tr_item(w13 + (size_t)1024 * 5632, 1024, 5632, (bf16_t*)(ws + WS_W13B), nullptr, 1, 176, scr, r, lane); continue; } r -= I13;
            if (r < I2) { tr_item(w2, 2816, 1024, (bf16_t*)(ws + WS_W2A), nullptr, 0, 32, scr, r, lane); continue; } r -= I2;
            if (r < I2) { tr_item(w2 + (size_t)2816 * 1024, 2816, 1024, (bf16_t*)(ws + WS_W2B), nullptr, 0, 32, scr, r, lane); continue; } r -= I2;
            if (r < IIN) { tr_item(win, 1024, 4000, (bf16_t*)(ws + WS_WIN), nullptr, 5, 128, scr, r, lane); continue; } r -= IIN;
            if (r < IUQ) { tr_item(wuq, 256, 768, (bf16_t*)(ws + WS_WUQ), qan, 2, 24, scr, r, lane); continue; } r -= IUQ;
            if (r < IUK) { tr_item(wukv, 128, 1024, (bf16_t*)(ws + WS_WUK), kvan, 3, 16, scr, r, lane); continue; } r -= IUK;
            if (r < IV) { tr_item(wukv, 128, 1024, (bf16_t*)(ws + WS_WV), kvan, 4, 16, scr, r, lane); continue; } r -= IV;
            if (r < IB) { tr_item(wbr, 512, 1024, (bf16_t*)(ws + WS_WB0), nullptr, 0, 32, scr, r, lane); continue; } r -= IB;
            if (r < IB) { tr_item(wbr + (size_t)512 * 1024, 512, 1024, (bf16_t*)(ws + WS_WB1), nullptr, 0, 32, scr, r, lane); continue; } r -= IB;
            tr_item(wout, 1024, 1024, (bf16_t*)(ws + WS_WOUT), nullptr, 0, 32, scr, r, lane);
        }
    }
    __syncthreads();
}

#define XB_TMO      128
#define XB_XCNT(j)  (256  + 64 * (j))
#define XB_XSUB(j)  (1280 + 64 * (j))
#define XB_XGEN(j)  (2304 + 64 * (j))
#define XB_TOP      3328
#define XB_TOPGEN   3392
#define XCD_BAR_WORDS 3456
#define XB_SPIN_CAP (1u << 22)
__device__ __forceinline__ unsigned xb_ld(unsigned* p)              { return __hip_atomic_load(p, __ATOMIC_RELAXED, __HIP_MEMORY_SCOPE_AGENT); }
__device__ __forceinline__ unsigned xb_add(unsigned* p, unsigned v) { return __hip_atomic_fetch_add(p, v, __ATOMIC_RELAXED, __HIP_MEMORY_SCOPE_AGENT); }
__device__ __forceinline__ unsigned xb_xcc_id() { return (unsigned)__builtin_amdgcn_s_getreg((3 << 11) | 20) & 0xFu; }
#define XB_SPIN(cond, bar) do { unsigned _sp = 0; while (cond) { __builtin_amdgcn_s_sleep(1); \
    if ((++_sp & 255u) == 0u) { if (xb_ld(&(bar)[XB_TMO])) break; if (_sp > XB_SPIN_CAP) { atomicAdd(&(bar)[XB_TMO], 1u); break; } } } } while (0)
struct XcdBarrier { unsigned* bar; unsigned x; volatile LAS unsigned* st; };
__device__ __forceinline__ XcdBarrier xcd_barrier_post(unsigned* bar, volatile LAS unsigned* st, int tid) {
    XcdBarrier b; b.bar = bar; b.x = xb_xcc_id(); b.st = st;
    if (tid == 0) (void)xb_add(&bar[XB_XCNT(b.x)], 1u);
    return b;
}
__device__ __forceinline__ void xcd_barrier_complete(unsigned* bar, unsigned x, unsigned& nloc, unsigned& nx) {
    const unsigned G = gridDim.x;
    unsigned sum, cnt, mine, sp = 0u;
    for (;;) {
        sum = 0u; cnt = 0u; mine = 0u;
#pragma unroll
        for (unsigned j = 0; j < 16; ++j) { const unsigned c = xb_ld(&bar[XB_XCNT(j)]); sum += c; cnt += (c > 0u) ? 1u : 0u; mine = (j == x) ? c : mine; }
        if (sum == G) break;
        __builtin_amdgcn_s_sleep(1);
        if ((++sp & 255u) == 0u) { if (xb_ld(&bar[XB_TMO])) break; if (sp > XB_SPIN_CAP) { atomicAdd(&bar[XB_TMO], 1u); break; } }
    }
    nloc = mine > 0u ? mine : 1u; nx = cnt > 0u ? cnt : 1u;
}
__device__ __forceinline__ void xcd_barrier(const XcdBarrier& b) {
    asm volatile("s_waitcnt vmcnt(0)" ::: "memory");
    __syncthreads();
    if (opq_tid() == 0) {
        unsigned* bar = b.bar;
        __builtin_amdgcn_s_waitcnt(0);
        unsigned nloc = b.st[0], nx = b.st[1];
        if (nloc == 0u) { xcd_barrier_complete(bar, b.x, nloc, nx); b.st[0] = nloc; b.st[1] = nx; }
        const unsigned old = xb_add(&bar[XB_XSUB(b.x)], 1u);
        const unsigned gen = old / nloc;
        if (old + 1u == (gen + 1u) * nloc) {
            __builtin_amdgcn_fence(__ATOMIC_RELEASE, "agent");
            asm volatile("s_waitcnt vmcnt(0)" ::: "memory");
            const unsigned og = xb_add(&bar[XB_TOP], 1u);
            const unsigned tg = og / nx;
            if (og + 1u == (tg + 1u) * nx) xb_add(&bar[XB_TOPGEN], 1u);
            else XB_SPIN(xb_ld(&bar[XB_TOPGEN]) == tg, bar);
            __builtin_amdgcn_fence(__ATOMIC_ACQUIRE, "agent");
            xb_add(&bar[XB_XGEN(b.x)], 1u);
            asm volatile("s_waitcnt vmcnt(0)" ::: "memory");
        } else {
            XB_SPIN(xb_ld(&bar[XB_XGEN(b.x)]) == gen, bar);
            __builtin_amdgcn_fence(__ATOMIC_ACQUIRE, "agent");
            asm volatile("s_waitcnt vmcnt(0)" ::: "memory");
        }
    }
    __syncthreads();
}

#ifndef MK_PER_PHASE
#define MK_PER_PHASE 0
#endif
__global__ void __launch_bounds__(512) fwd_kernel(Args A) {
    extern __shared__ __attribute__((aligned(16))) unsigned char lds_raw[];
    LAS unsigned char* lds = (LAS unsigned char*)lds_raw;
    cg::grid_group grid = cg::this_grid();
    const int G = gridDim.x, cidx = blockIdx.x;
    { const int t0 = opq_tid(); if (t0 < 32) ((LAS unsigned*)(lds + LDS_MISC))[t0] = 0u; __syncthreads(); }
    if (blockIdx.x == 0) { GAS u32x4* bz = (GAS u32x4*)(opq(A.ws) + WS_BAR); const int t0 = opq_tid(); bz[t0] = (u32x4){0u, 0u, 0u, 0u}; bz[512 + t0] = (u32x4){0u, 0u, 0u, 0u}; }
    const int lo = A.ph_lo, hi = A.ph_hi; (void)lo; (void)hi;
#if MK_PER_PHASE
#define IN(k) (lo <= (k) && (k) < hi)
#define SEAM(k) do { } while (0)
#else
#define IN(k) true
#define SEAM(k) do { if ((k) == 0) grid.sync(); else { XcdBarrier xb_; xb_.bar = (unsigned*)(opq(A.ws) + WS_BAR); xb_.x = xb_xcc_id(); xb_.st = (volatile LAS unsigned*)(lds + LDS_MISC); xcd_barrier(xb_); } } while (0)
#endif
#define WSP(T_, off) ((T_*)(ws + (off)))
#ifndef DUP
#define DUP 0
#endif
#if DUP
#define REP(k) for (int rep_ = 0; rep_ <= ((DUP >> (k)) & 1); ++rep_)
#else
#define REP(k)
#endif
    using namespace pg8;

    REP(0) { if (IN(0)) { prologue(A, lds); } SEAM(0); }
    (void)xcd_barrier_post((unsigned*)(opq(A.ws) + WS_BAR), (volatile LAS unsigned*)(lds + LDS_MISC), opq_tid());
    REP(1) { if (IN(1)) { xa_phase(A, lds); } SEAM(1); }
    REP(2) { if (IN(2)) { unsigned char* ws = opq(A.ws); Gemm g{WSP(const bf16_t, WS_H), WSP(const bf16_t, WS_W13A), T, 2 * FF, DM, DM, DM}; StaticOrder S; S.init(T, 2 * FF, G, cidx);
        EpiSwiGLU E{WSP(bf16_t, WS_BIG), WSP(const float, WS_SSP), WSP(const float, WS_SHW0)}; gemm_phase<EpiSwiGLU, StaticOrder, true>(lds, g, S, E); } SEAM(2); }
    REP(3) { if (IN(3)) { unsigned char* ws = opq(A.ws); Gemm g{WSP(const bf16_t, WS_BIG), WSP(const bf16_t, WS_W2A), T, DM, FF, FF, FF}; StaticOrder S; S.init(T, DM, G, cidx);
        EpiResidN<0> E{opq((const float*)A.in[0]), opq(A.out), WSP(bf16_t, WS_H), WSP(float, WS_SSP), WSP(const float, WS_MOD) + 0 * 3072 + 2048, WSP(const float, WS_AVEC), 0.5f};
        gemm_phase<EpiResidN<0>, StaticOrder, true>(lds, g, S, E); } SEAM(3); }
    REP(5) { if (IN(5)) { unsigned char* ws = opq(A.ws); Gemm g{WSP(const bf16_t, WS_H), WSP(const bf16_t, WS_WIN), T, PROJ_LD, DM, DM, DM}; StaticOrder S; S.init(T, PROJ_LD, G, cidx);
        EpiProj E{WSP(bf16_t, WS_BIG), WSP(const float, WS_SSP), WSP(const float, WS_SHW1)}; gemm_phase<EpiProj, StaticOrder, true>(lds, g, S, E); } SEAM(5); }
    REP(6) { if (IN(6)) { unsigned char* ws = opq(A.ws); conv_phase(WSP(const bf16_t, WS_BIG), (const float*)A.in[17], (const float*)A.in[16], WSP(const float, WS_COS), WSP(const float, WS_SIN),
        WSP(float, WS_RSTDQ), WSP(float, WS_RSTDKV), WSP(bf16_t, WS_KR), WSP(bf16_t, WS_OCONV)); } SEAM(6); }
    REP(7) { if (IN(7)) {
        { unsigned char* ws = opq(A.ws); Gemm g{WSP(const bf16_t, WS_BIG), WSP(const bf16_t, WS_WUQ), T, 768, 256, PROJ_LD, 256}; StaticOrder S; S.init(T, 768, G, cidx);
          EpiQK<2> E{WSP(bf16_t, WS_Q), QLD, 96, WSP(const float, WS_RSTDQ), (const float*)A.in[13], (const float*)A.in[15], WSP(const float, WS_COS), WSP(const float, WS_SIN), QSCALE};
          gemm_phase<EpiQK<2>, StaticOrder, true>(lds, g, S, E); }
        { unsigned char* ws = opq(A.ws); Gemm g{WSP(const bf16_t, WS_BIG) + 256, WSP(const bf16_t, WS_WUK), T, 512, 128, PROJ_LD, 128}; StaticOrder S; S.init(T, 512, G, cidx);
          EpiQK<-1> E{WSP(bf16_t, WS_KN), 512, 64, WSP(const float, WS_RSTDKV), (const float*)A.in[14], nullptr, nullptr, nullptr, 1.0f};
          gemm_phase<EpiQK<-1>, StaticOrder, true>(lds, g, S, E); }
        { unsigned char* ws = opq(A.ws); Gemm g{WSP(const bf16_t, WS_WV), WSP(const bf16_t, WS_BIG) + 256, 512, T, 128, 128, PROJ_LD}; StaticOrder S; S.init(512, T, G, cidx);
          EpiVT E{WSP(bf16_t, WS_VT), WSP(const float, WS_RSTDKV)}; gemm_phase<EpiVT, StaticOrder, true>(lds, g, S, E); }
    } SEAM(7); }
    REP(8) { if (IN(8)) { unsigned char* ws = opq(A.ws); att::phase(lds, WSP(const bf16_t, WS_Q), WSP(const bf16_t, WS_KN), WSP(const bf16_t, WS_KR), WSP(const bf16_t, WS_VT), WSP(bf16_t, WS_OATT)); } SEAM(8); }
    REP(9) { if (IN(9)) {
        { unsigned char* ws = opq(A.ws); Gemm g{WSP(const bf16_t, WS_OATT), WSP(const bf16_t, WS_WB0), T, DM, 512, 512, 512}; StaticOrder S; S.init(T, DM, G, cidx);
          EpiBranch<true> E{WSP(bf16_t, WS_MERGED), WSP(const bf16_t, WS_BIG) + C_GL}; gemm_phase<EpiBranch<true>, StaticOrder, true>(lds, g, S, E); }
        { unsigned char* ws = opq(A.ws); Gemm g{WSP(const bf16_t, WS_OCONV), WSP(const bf16_t, WS_WB1), T, DM, 512, 512, 512}; StaticOrder S; S.init(T, DM, G, cidx);
          EpiBranch<false> E{WSP(bf16_t, WS_MERGED), WSP(const bf16_t, WS_BIG) + C_GL + 1024}; gemm_phase<EpiBranch<false>, StaticOrder, true>(lds, g, S, E); }
    } SEAM(9); }
    REP(10) { if (IN(10)) { unsigned char* ws = opq(A.ws); Gemm g{WSP(const bf16_t, WS_MERGED), WSP(const bf16_t, WS_WOUT), T, DM, DM, DM, DM}; StaticOrder S; S.init(T, DM, G, cidx);
        EpiResidN<1> E{opq(A.out), WSP(bf16_t, WS_X2B), WSP(bf16_t, WS_H), WSP(float, WS_SSP), WSP(const float, WS_MOD) + 1 * 3072 + 2048, WSP(const float, WS_AVEC) + 8 * 1024, 1.0f};
        gemm_phase<EpiResidN<1>, StaticOrder, true>(lds, g, S, E); } SEAM(10); }
    REP(12) { if (IN(12)) { unsigned char* ws = opq(A.ws); Gemm g{WSP(const bf16_t, WS_H), WSP(const bf16_t, WS_W13B), T, 2 * FF, DM, DM, DM}; StaticOrder S; S.init(T, 2 * FF, G, cidx);
        EpiSwiGLU E{WSP(bf16_t, WS_BIG), WSP(const float, WS_SSP), WSP(const float, WS_SHW2)}; gemm_phase<EpiSwiGLU, StaticOrder, true>(lds, g, S, E); } SEAM(12); }
    if (IN(13)) { unsigned char* ws = opq(A.ws); Gemm g{WSP(const bf16_t, WS_BIG), WSP(const bf16_t, WS_W2B), T, DM, FF, FF, FF}; StaticOrder S; S.init(T, DM, G, cidx);
        EpiResidN<2> E{WSP(const bf16_t, WS_X2B), opq(A.out), nullptr, nullptr, WSP(const float, WS_MOD) + 2 * 3072 + 2048, nullptr, 0.5f};
        gemm_phase<EpiResidN<2>, StaticOrder, true>(lds, g, S, E); }
#undef IN
#undef SEAM
#undef WSP
#undef REP
}

extern "C" void kernel_launch(void* const* d_in, const int* in_sizes, int n_in, void* d_out, int out_size, void* d_ws, size_t ws_size, hipStream_t stream) {
    static int grid = 0;
    if (grid == 0) {
        if (n_in != 20 || out_size != T * DM || ws_size < WS_END) { fprintf(stderr, "kernel_launch: unexpected shapes (n_in %d out %d ws %zu)\n", n_in, out_size, ws_size); grid = -1; return; }
        int dev = 0, cus = 0, per_cu = 0;
        hipGetDevice(&dev); hipDeviceGetAttribute(&cus, hipDeviceAttributeMultiprocessorCount, dev);
        if (hipFuncSetAttribute((const void*)fwd_kernel, hipFuncAttributeMaxDynamicSharedMemorySize, LDS_BYTES) != hipSuccess) { fprintf(stderr, "kernel_launch: hipFuncSetAttribute failed\n"); grid = -1; return; }
        if (hipOccupancyMaxActiveBlocksPerMultiprocessor(&per_cu, (const void*)fwd_kernel, 512, LDS_BYTES) != hipSuccess || per_cu < 1) per_cu = 1;
        (void)hipGetLastError();
        grid = cus * per_cu;
        if (grid > 256) grid = 256;
    }
    if (grid < 0) return;
    Args a{};
    for (int i = 0; i < 20; ++i) a.in[i] = d_in[i];
    a.out = (float*)d_out; a.ws = (unsigned char*)d_ws;
#if MK_PER_PHASE
    for (int p = 0; p < 14; ++p) { a.ph_lo = p; a.ph_hi = p + 1; hipLaunchKernelGGL(fwd_kernel, dim3(grid), dim3(512), LDS_BYTES, stream, a); }
#else
    a.ph_lo = 0; a.ph_hi = 14;
    void* args[] = {&a};
    hipError_t e = hipLaunchCooperativeKernel((const void*)fwd_kernel, dim3(grid), dim3(512), args, LDS_BYTES, stream);
    if (e != hipSuccess) fprintf(stderr, "cooperative launch failed: %s (grid %d)\n", hipGetErrorString(e), grid);
#endif
}
```

```cpp
#include <hip/hip_runtime.h>
#include <hip/hip_cooperative_groups.h>
#include <cstdio>
#include <cstdint>
namespace cg = cooperative_groups;

#define LAS __attribute__((address_space(3)))
#define GAS __attribute__((address_space(1)))
typedef unsigned short bf16_t;
typedef short bf16x8 __attribute__((ext_vector_type(8)));
typedef float f32x4 __attribute__((ext_vector_type(4)));
typedef float f32x16 __attribute__((ext_vector_type(16)));
typedef unsigned u32x4 __attribute__((ext_vector_type(4)));
typedef unsigned u32x2 __attribute__((ext_vector_type(2)));

constexpr int BATCH = 8, SEQ = 8192, T = BATCH * SEQ, DM = 1024, FF = 2816, NH = 8;
constexpr int QLD = 768, PROJ_LD = 4096, MODLD = 9216;
constexpr int C_CONV = 416, C_GB = 928, C_GC = 1440, C_GL = 1952;
constexpr float EPS = 1e-6f;
constexpr float QSCALE = 0.10206207261596577f * 1.4426950408889634f;

constexpr size_t MiB = 1u << 20;
constexpr size_t WS_MOD = 0, WS_RSTDQ = 1 * MiB, WS_RSTDKV = 1 * MiB + 512 * 1024, WS_COS = 2 * MiB, WS_SIN = 6 * MiB, WS_KR = 10 * MiB;
constexpr size_t WS_W13A = 16 * MiB, WS_W13B = 27 * MiB, WS_W2A = 38 * MiB, WS_W2B = 38 * MiB + 5632 * 1024, WS_WIN = 49 * MiB;
constexpr size_t WS_WUQ = 57 * MiB, WS_WUK = 57 * MiB + 512 * 1024, WS_WV = 57 * MiB + 768 * 1024, WS_WB0 = 58 * MiB, WS_WB1 = 59 * MiB, WS_WOUT = 60 * MiB;
constexpr size_t WS_H = 64 * MiB, WS_OATT = 64 * MiB, WS_OCONV = 128 * MiB;
constexpr size_t WS_BIG = 192 * MiB;
constexpr size_t WS_Q = 704 * MiB, WS_KN = 800 * MiB, WS_MERGED = 704 * MiB, WS_VT = 864 * MiB, WS_SSP = 928 * MiB, WS_END = 932 * MiB;
constexpr size_t WS_SHW0 = 14 * MiB, WS_SHW1 = 14 * MiB + 256 * 1024, WS_SHW2 = 14 * MiB + 512 * 1024, WS_AVEC = 14 * MiB + 768 * 1024;
constexpr size_t WS_X2B = 544 * MiB;

constexpr size_t WS_BAR = 15 * MiB, BAR_BYTES = 16384;
constexpr int LDS_BYTES = 147456, LDS_MISC = 131072 + 320;

template <class P> __device__ __forceinline__ P* opq(P* p) { asm volatile("" : "+s"(p)); return p; }
__device__ __forceinline__ int opq_tid() { int t = threadIdx.x; asm volatile("" : "+v"(t)); return t; }
__device__ __forceinline__ unsigned cvt_pk_bf16(float lo, float hi) { unsigned r; asm("v_cvt_pk_bf16_f32 %0, %1, %2" : "=v"(r) : "v"(lo), "v"(hi)); return r; }
__device__ __forceinline__ float bf_lo(unsigned w) { return __uint_as_float(w << 16); }
__device__ __forceinline__ float bf_hi(unsigned w) { return __uint_as_float(w & 0xffff0000u); }
__device__ __forceinline__ float fast_sigmoid(float x) { return __builtin_amdgcn_rcpf(1.0f + __expf(-x)); }
__device__ __forceinline__ u32x4 pack8(f32x4 a, f32x4 b) { u32x4 w; w.x = cvt_pk_bf16(a[0], a[1]); w.y = cvt_pk_bf16(a[2], a[3]); w.z = cvt_pk_bf16(b[0], b[1]); w.w = cvt_pk_bf16(b[2], b[3]); return w; }
__device__ __forceinline__ float wave_sum(float v) {
#pragma unroll
    for (int o = 1; o < 64; o <<= 1) v += __shfl_xor(v, o);
    return v;
}

namespace pg8 {
constexpr int BM = 256, BK = 64, HALF = 128, HTB = HALF * BK * 2, STAGE_BYTES = 8 * HTB, NXCD = 8, WGM = 8;
__host__ __device__ __forceinline__ int lds_byte(int r, int c) { const int st = (r >> 4) * 2 + (c >> 5), rr = r & 15, cc = c & 31, ob = rr * 64 + cc * 2; return st * 1024 + (ob ^ (((ob >> 9) & 1) << 5)); }
__host__ __device__ __forceinline__ void stage_rc(int b, int& R, int& C) { const int st = b / 1024, sb = b % 1024, swz = sb ^ (((sb >> 9) & 1) << 5); R = (st >> 1) * 16 + swz / 64; C = (st & 1) * 32 + (swz % 64) / 2; }
__host__ __device__ __forceinline__ int perm32(int rho) { const int n = rho >> 4, i = rho & 15; return 8 * (i >> 2) + 4 * n + (i & 3); }

struct Unit { int pm, pn; };
struct Gemm { const bf16_t* A; const bf16_t* Bt; int M, N, K, lda, ldb; };

struct StaticOrder {
    int nM, nN, nwg, G, c;
    __host__ __device__ void init(int M, int N, int G_, int c_) { nM = M / BM; nN = N / BM; nwg = nM * nN; G = G_; c = c_; }
    __host__ __device__ bool next(int i, Unit& u) const {
        const long L = (long)i * G + c; if (L >= nwg) return false;
        int wgid = (int)L; { const int q = nwg / NXCD, r = nwg % NXCD, xcd = wgid % NXCD, off = wgid / NXCD; wgid = (xcd < r ? xcd * (q + 1) : r * (q + 1) + (xcd - r) * q) + off; }
        const int nig = WGM * nN, gid = wgid / nig, fm = gid * WGM, gsz = (nM - fm) < WGM ? (nM - fm) : WGM;
        u.pm = fm + ((wgid % nig) % gsz); u.pn = (wgid % nig) / gsz; return true;
    }
};

template <class Epi, class Sched, bool ALIGN_EPI>
__device__ __forceinline__ void gemm_phase(LAS unsigned char* lds, const Gemm g, const Sched& S, const Epi& E) {
    int tid_ = threadIdx.x; asm volatile("" : "+v"(tid_));
    const int tid = tid_, wid = __builtin_amdgcn_readfirstlane(tid >> 6), lane = tid & 63, wr = wid >> 2, wc = wid & 3, fr = lane & 15, fq = lane >> 4;
    const int K = g.K, nt = K / BK;
    unsigned voffA[2], voffB[2];
#pragma unroll
    for (int i = 0; i < 2; ++i) { int R, C; stage_rc(tid * 16 + i * 8192, R, C); const int Rb = Epi::PERM ? ((R & ~31) + perm32(R & 31)) : R;
        voffA[i] = (unsigned)(R * g.lda + C) * 2u; voffB[i] = (unsigned)(Rb * g.ldb + C) * 2u; }
    const size_t kstep = (size_t)(BK * 2);
    const size_t hstepA = (size_t)HALF * g.lda * 2, hstepB = (size_t)HALF * g.ldb * 2;
    const size_t tstepA = 2 * hstepA, tstepB = 2 * hstepB;
    const unsigned ldsw = (unsigned)wid * 1024u;
    const int aoff = lds_byte(wr * 64 + fr, fq * 8), boff = lds_byte(wc * 32 + fr, fq * 8);
#define PG8_SA(b, h) (((b) * 2 + (h)) * HTB)
#define PG8_SB(b, h) ((4 + (b) * 2 + (h)) * HTB)
#define PG8_STAGE(bufoff, gbase, voff) do { _Pragma("unroll") for (int _i = 0; _i < 2; ++_i) \
        __builtin_amdgcn_global_load_lds((const unsigned*)((const char*)(gbase) + (voff)[_i]), (LAS unsigned*)(lds + (bufoff) + ldsw + _i * 8192), 16, 0, 0); } while (0)
#define PG8_LDA(dst, b, h) do { _Pragma("unroll") for (int m = 0; m < 4; ++m) _Pragma("unroll") for (int k = 0; k < 2; ++k) dst[m][k] = *(const LAS bf16x8*)(lds + PG8_SA(b, h) + aoff + m * 2048 + k * 1024); } while (0)
#define PG8_LDB(dst, b, h) do { _Pragma("unroll") for (int n = 0; n < 2; ++n) _Pragma("unroll") for (int k = 0; k < 2; ++k) dst[n][k] = *(const LAS bf16x8*)(lds + PG8_SB(b, h) + boff + n * 2048 + k * 1024); } while (0)
#define PG8_MMA(ai, bj, At, Bt) do { _Pragma("unroll") for (int m = 0; m < 4; ++m) _Pragma("unroll") for (int n = 0; n < 2; ++n) _Pragma("unroll") for (int k = 0; k < 2; ++k) \
        acc[ai][bj][m][n] = __builtin_amdgcn_mfma_f32_16x16x32_bf16(Bt[n][k], At[m][k], acc[ai][bj][m][n], 0, 0, 0); } while (0)
#define PG8_WAIT_V(n) asm volatile("s_waitcnt vmcnt(" #n ")" ::: "memory")
#define PG8_WAIT_L(n) asm volatile("s_waitcnt lgkmcnt(" #n ")" ::: "memory")
#define PG8_BAR __builtin_amdgcn_s_barrier()
#define PG8_SCHED __builtin_amdgcn_sched_barrier(0)
    Unit cur, nxt; int ui = 0;
    if (!S.next(0, cur)) return;
    f32x4 acc[2][2][4][2];
#pragma unroll
    for (int a = 0; a < 2; ++a)
#pragma unroll
        for (int b = 0; b < 2; ++b)
#pragma unroll
            for (int m = 0; m < 4; ++m)
#pragma unroll
                for (int n = 0; n < 2; ++n) acc[a][b][m][n] = (f32x4){0.f, 0.f, 0.f, 0.f};
    bf16x8 At[4][2], B0[2][2], B1[2][2];
    const char* cA = (const char*)g.A + (size_t)cur.pm * tstepA; const char* cB = (const char*)g.Bt + (size_t)cur.pn * tstepB;
    PG8_STAGE(PG8_SB(0, 0), cB, voffB); PG8_STAGE(PG8_SB(0, 1), cB + hstepB, voffB); PG8_STAGE(PG8_SA(0, 0), cA, voffA); PG8_STAGE(PG8_SA(0, 1), cA + hstepA, voffA);
    if (wr == 1) PG8_BAR;
    PG8_WAIT_V(2); PG8_BAR;
    PG8_STAGE(PG8_SB(1, 0), cB + kstep, voffB); PG8_STAGE(PG8_SA(1, 0), cA + kstep, voffA); PG8_STAGE(PG8_SB(1, 1), cB + hstepB + kstep, voffB);
    PG8_WAIT_V(6); PG8_BAR;
    for (;;) {
        const bool has_next = S.next(ui + 1, nxt);
        const char* nA = has_next ? (const char*)g.A + (size_t)nxt.pm * tstepA : cA; const char* nB = has_next ? (const char*)g.Bt + (size_t)nxt.pn * tstepB : cB;
        for (int t = 0; t < nt; t += 2) {
            const bool last = (t == nt - 2);
            const char* a1 = cA + (size_t)(t + 1) * kstep;
            const char* a2 = last ? nA : cA + (size_t)(t + 2) * kstep; const char* b2 = last ? nB : cB + (size_t)(t + 2) * kstep;
            const char* a3 = a2 + kstep; const char* b3 = b2 + kstep;
            PG8_LDB(B0, 0, 0); PG8_LDB(B1, 0, 1); PG8_SCHED; PG8_LDA(At, 0, 0); PG8_STAGE(PG8_SA(1, 1), a1 + hstepA, voffA);
            PG8_WAIT_V(8); PG8_WAIT_L(0); PG8_BAR; __builtin_amdgcn_s_setprio(1); PG8_MMA(0, 0, At, B0); PG8_MMA(0, 1, At, B1); __builtin_amdgcn_s_setprio(0); PG8_BAR; PG8_SCHED;
            PG8_LDA(At, 0, 1); PG8_STAGE(PG8_SB(0, 0), b2, voffB); PG8_STAGE(PG8_SB(0, 1), b2 + hstepB, voffB); PG8_STAGE(PG8_SA(0, 0), a2, voffA);
            PG8_WAIT_V(8); PG8_WAIT_L(0); PG8_BAR; __builtin_amdgcn_s_setprio(1); PG8_MMA(1, 0, At, B0); PG8_MMA(1, 1, At, B1); __builtin_amdgcn_s_setprio(0); PG8_BAR; PG8_SCHED;
            PG8_LDB(B0, 1, 0); PG8_LDB(B1, 1, 1); PG8_SCHED; PG8_LDA(At, 1, 0); PG8_STAGE(PG8_SA(0, 1), a2 + hstepA, voffA);
            PG8_WAIT_V(8); PG8_WAIT_L(0); PG8_BAR; __builtin_amdgcn_s_setprio(1); PG8_MMA(0, 0, At, B0); PG8_MMA(0, 1, At, B1); __builtin_amdgcn_s_setprio(0); PG8_BAR; PG8_SCHED;
            PG8_LDA(At, 1, 1); PG8_STAGE(PG8_SB(1, 0), b3, voffB); PG8_STAGE(PG8_SB(1, 1), b3 + hstepB, voffB); PG8_STAGE(PG8_SA(1, 0), a3, voffA);
            PG8_WAIT_V(8); PG8_WAIT_L(0); PG8_BAR; __builtin_amdgcn_s_setprio(1); PG8_MMA(1, 0, At, B0); PG8_MMA(1, 1, At, B1); __builtin_amdgcn_s_setprio(0); PG8_BAR; PG8_SCHED;
        }
        if constexpr (ALIGN_EPI) { if (wr == 0) PG8_BAR; }
        { int fr_ = fr, fq_ = fq; asm volatile("" : "+v"(fr_), "+v"(fq_)); E(acc, cur, wr, wc, fr_, fq_); }
        if (!has_next) break;
#pragma unroll
        for (int a = 0; a < 2; ++a)
#pragma unroll
            for (int b = 0; b < 2; ++b)
#pragma unroll
                for (int m = 0; m < 4; ++m)
#pragma unroll
                    for (int n = 0; n < 2; ++n) acc[a][b][m][n] = (f32x4){0.f, 0.f, 0.f, 0.f};
        cur = nxt; cA = nA; cB = nB; ++ui;
        if constexpr (ALIGN_EPI) { if (wr == 1) PG8_BAR; }
    }
    PG8_WAIT_V(0);
    if constexpr (!ALIGN_EPI) { if (wr == 0) PG8_BAR; }
    PG8_BAR;
#undef PG8_SA
#undef PG8_SB
#undef PG8_STAGE
#undef PG8_LDA
#undef PG8_LDB
#undef PG8_MMA
#undef PG8_WAIT_V
#undef PG8_WAIT_L
#undef PG8_BAR
#undef PG8_SCHED
}

typedef f32x4 Acc[2][2][4][2];

struct EpiStoreBf16 { static constexpr bool PERM = true; bf16_t* O; int ldc;
    __device__ __forceinline__ void operator()(const Acc& acc, const Unit& u, int wr, int wc, int fr, int fq) const {
        const int row0 = u.pm * BM + wr * 64 + fr, col0 = u.pn * BM + wc * 32 + 8 * fq;
#pragma unroll
        for (int ai = 0; ai < 2; ++ai)
#pragma unroll
            for (int m = 0; m < 4; ++m) { bf16_t* rowp = O + (size_t)(row0 + ai * HALF + m * 16) * ldc + col0;
#pragma unroll
                for (int bj = 0; bj < 2; ++bj) *(GAS u32x4*)(rowp + bj * HALF) = pack8(acc[ai][bj][m][0], acc[ai][bj][m][1]); }
    }
};
__device__ __forceinline__ void rstd8_from_ssp(const float* ssp, int row0, int fq, float (&rs)[2][4]) {
    f32x4 p[2][4];
#pragma unroll
    for (int ai = 0; ai < 2; ++ai)
#pragma unroll
        for (int m = 0; m < 4; ++m) p[ai][m] = *(const GAS f32x4*)(ssp + (size_t)(row0 + ai * 128 + m * 16) * 16 + 4 * fq);
#pragma unroll
    for (int ai = 0; ai < 2; ++ai)
#pragma unroll
        for (int m = 0; m < 4; ++m) { float v = (p[ai][m][0] + p[ai][m][1]) + (p[ai][m][2] + p[ai][m][3]); v += __shfl_xor(v, 16); v += __shfl_xor(v, 32); rs[ai][m] = rsqrtf(v * (1.0f / DM) + EPS); }
}
struct EpiSwiGLU { static constexpr bool PERM = true; bf16_t* O; const float* ssp; const float* shw;
    __device__ __forceinline__ void operator()(const Acc& acc, const Unit& u, int wr, int wc, int fr, int fq) const {
        const int row0 = u.pm * BM + wr * 64 + fr, col0 = u.pn * HALF + wc * 32 + 8 * fq, b = u.pm >> 5;
        f32x4 sg[2], su[2];
#pragma unroll
        for (int n = 0; n < 2; ++n) { sg[n] = *(const GAS f32x4*)(shw + (size_t)b * (2 * FF) + col0 + 4 * n); su[n] = *(const GAS f32x4*)(shw + (size_t)b * (2 * FF) + FF + col0 + 4 * n); }
        float rs8[2][4]; rstd8_from_ssp(ssp, row0, fq, rs8);
#pragma unroll
        for (int ai = 0; ai < 2; ++ai)
#pragma unroll
            for (int m = 0; m < 4; ++m) { const int row = row0 + ai * HALF + m * 16; const float rs = rs8[ai][m];
                bf16_t* rowp = O + (size_t)row * FF + col0;
                f32x4 o[2];
#pragma unroll
                for (int n = 0; n < 2; ++n)
#pragma unroll
                    for (int e = 0; e < 4; ++e) { const float gg = acc[ai][0][m][n][e] * rs + sg[n][e], uu = acc[ai][1][m][n][e] * rs + su[n][e]; o[n][e] = gg * fast_sigmoid(gg) * uu; }
                *(GAS u32x4*)rowp = pack8(o[0], o[1]);
                asm volatile("" ::: "memory"); }
    }
};
struct EpiProj { static constexpr bool PERM = true; bf16_t* O; const float* ssp; const float* shw;
    __device__ __forceinline__ void operator()(const Acc& acc, const Unit& u, int wr, int wc, int fr, int fq) const {
        const int row0 = u.pm * BM + wr * 64 + fr, col0 = u.pn * BM + wc * 32 + 8 * fq, b = u.pm >> 5;
        float rs8[2][4]; rstd8_from_ssp(ssp, row0, fq, rs8);
#pragma unroll
        for (int ai = 0; ai < 2; ++ai)
#pragma unroll
            for (int m = 0; m < 4; ++m) { const int row = row0 + ai * HALF + m * 16; const float rs = rs8[ai][m];
                bf16_t* rowp = O + (size_t)row * PROJ_LD + col0;
#pragma unroll
                for (int bj = 0; bj < 2; ++bj) { const f32x4 h0 = *(const GAS f32x4*)(shw + (size_t)b * PROJ_LD + col0 + bj * HALF), h1 = *(const GAS f32x4*)(shw + (size_t)b * PROJ_LD + col0 + bj * HALF + 4);
                    *(GAS u32x4*)(rowp + bj * HALF) = pack8(acc[ai][bj][m][0] * rs + h0, acc[ai][bj][m][1] * rs + h1); }
                asm volatile("" ::: "memory"); }
    }
};
template <int MODE> struct EpiResidN { static constexpr bool PERM = true; const void* base; void* xout; bf16_t* xa; float* ssp; const float* gate; const float* avec; float s;
    __device__ __forceinline__ void operator()(const Acc& acc, const Unit& u, int wr, int wc, int fr, int fq) const {
        const int row0 = u.pm * BM + wr * 64 + fr, col0 = u.pn * BM + wc * 32 + 8 * fq, b = u.pm >> 5;
        float ss[2][4];
#pragma unroll
        for (int ai = 0; ai < 2; ++ai)
#pragma unroll
            for (int m = 0; m < 4; ++m) ss[ai][m] = 0.f;
#pragma unroll
        for (int bj = 0; bj < 2; ++bj) { const int c = col0 + bj * HALF;
            const f32x4 g0 = *(const GAS f32x4*)(gate + (size_t)b * MODLD + c) * s, g1 = *(const GAS f32x4*)(gate + (size_t)b * MODLD + c + 4) * s;
            f32x4 a0 = {0.f, 0.f, 0.f, 0.f}, a1 = {0.f, 0.f, 0.f, 0.f};
            if (MODE < 2) { a0 = *(const GAS f32x4*)(avec + (size_t)b * DM + c); a1 = *(const GAS f32x4*)(avec + (size_t)b * DM + c + 4); }
            constexpr int NB = MODE == 0 ? 2 : 4;
#pragma unroll
            for (int r0 = 0; r0 < 8; r0 += NB) {
                f32x4 bf[NB][2]; u32x4 bw[NB];
#pragma unroll
                for (int q = 0; q < NB; ++q) { const int ai = (r0 + q) >> 2, m = (r0 + q) & 3; const size_t off = (size_t)(row0 + ai * HALF + m * 16) * DM + c;
                    if (MODE == 0) { bf[q][0] = *(const GAS f32x4*)((const float*)base + off); bf[q][1] = *(const GAS f32x4*)((const float*)base + off + 4); }
                    else bw[q] = *(const GAS u32x4*)((const bf16_t*)base + off); }
#pragma unroll
                for (int q = 0; q < NB; ++q) { const int ai = (r0 + q) >> 2, m = (r0 + q) & 3; const size_t off = (size_t)(row0 + ai * HALF + m * 16) * DM + c;
                    f32x4 b0, b1;
                    if (MODE == 0) { b0 = bf[q][0]; b1 = bf[q][1]; }
                    else { const u32x4 w = bw[q]; b0 = (f32x4){bf_lo(w.x), bf_hi(w.x), bf_lo(w.y), bf_hi(w.y)}; b1 = (f32x4){bf_lo(w.z), bf_hi(w.z), bf_lo(w.w), bf_hi(w.w)}; }
                    const f32x4 o0 = b0 + g0 * acc[ai][bj][m][0], o1 = b1 + g1 * acc[ai][bj][m][1];
                    if (MODE == 2) { *(GAS f32x4*)((float*)xout + off) = o0; *(GAS f32x4*)((float*)xout + off + 4) = o1; }
                    else { *(GAS u32x4*)((bf16_t*)xout + off) = pack8(o0, o1); *(GAS u32x4*)(xa + off) = pack8(o0 * a0, o1 * a1);
                        const f32x4 q0 = o0 * o0, q1 = o1 * o1; ss[ai][m] += ((q0[0] + q0[1]) + (q0[2] + q0[3])) + ((q1[0] + q1[1]) + (q1[2] + q1[3])); } }
                asm volatile("" ::: "memory");
            }
        }
        if (MODE < 2) {
#pragma unroll
            for (int ai = 0; ai < 2; ++ai)
#pragma unroll
                for (int m = 0; m < 4; ++m) { float v = ss[ai][m]; v += __shfl_xor(v, 16); v += __shfl_xor(v, 32);
                    if (fq == 0) ((GAS float*)ssp)[(size_t)(row0 + ai * HALF + m * 16) * 16 + u.pn * 4 + wc] = v; }
        }
    }
};
struct EpiVT { static constexpr bool PERM = true; bf16_t* O; const float* rstd;
    __device__ __forceinline__ void operator()(const Acc& acc, const Unit& u, int wr, int wc, int fr, int fq) const {
        const int row0 = u.pm * BM + wr * 64 + fr, col0 = u.pn * BM + wc * 32 + 8 * fq;
#pragma unroll
        for (int ai = 0; ai < 2; ++ai)
#pragma unroll
            for (int m = 0; m < 4; ++m) { bf16_t* rowp = O + (size_t)(row0 + ai * HALF + m * 16) * T + col0;
#pragma unroll
                for (int bj = 0; bj < 2; ++bj) *(GAS u32x4*)(rowp + bj * HALF) = pack8(acc[ai][bj][m][0], acc[ai][bj][m][1]); }
    }
};
template <int ROPE_TILE> struct EpiQK { static constexpr bool PERM = true; bf16_t* O; int ldo, hw; const float* rstd; const float* wn; const float* wrp; const float* cosT; const float* sinT; float c2;
    __device__ __forceinline__ void operator()(const Acc& acc, const Unit& u, int wr, int wc, int fr, int fq) const {
        const int row0 = u.pm * BM + wr * 64 + fr;
        const float* wn = this->wn; const float* wrp = this->wrp;
        asm volatile("" : "+s"(wn), "+s"(wrp));
        if (ROPE_TILE < 0 || u.pn != ROPE_TILE) {
            const int head = 4 * u.pn + wc;
#pragma unroll
            for (int ai = 0; ai < 2; ++ai)
#pragma unroll
                for (int m = 0; m < 4; ++m) { const int row = row0 + ai * HALF + m * 16; const float rs = 1.0f;
                    float ss = 0.f;
#pragma unroll
                    for (int bj = 0; bj < 2; ++bj)
#pragma unroll
                        for (int n = 0; n < 2; ++n) { const f32x4 q = acc[ai][bj][m][n] * acc[ai][bj][m][n]; ss += (q[0] + q[1]) + (q[2] + q[3]); }
                    ss += __shfl_xor(ss, 16); ss += __shfl_xor(ss, 32);
                    const float f = rs * rsqrtf(ss * rs * rs * (1.0f / 64.0f) + EPS) * c2;
                    bf16_t* rowp = O + (size_t)row * ldo + head * hw + 8 * fq;
#pragma unroll
                    for (int bj = 0; bj < 2; ++bj) { const f32x4 w0 = *(const GAS f32x4*)(wn + 32 * bj + 8 * fq), w1 = *(const GAS f32x4*)(wn + 32 * bj + 8 * fq + 4);
                        *(GAS u32x4*)(rowp + 32 * bj) = pack8(acc[ai][bj][m][0] * f * w0, acc[ai][bj][m][1] * f * w1); }
                    asm volatile("" ::: "memory"); }
        } else {
            const float sgn = (fq < 2) ? -1.0f : 1.0f;
#pragma unroll
            for (int ai = 0; ai < 2; ++ai)
#pragma unroll
                for (int m = 0; m < 4; ++m) { const int row = row0 + ai * HALF + m * 16; const float rs = 1.0f;
#pragma unroll
                    for (int bj = 0; bj < 2; ++bj) { float ss = 0.f;
#pragma unroll
                        for (int n = 0; n < 2; ++n) { const f32x4 q = acc[ai][bj][m][n] * acc[ai][bj][m][n]; ss += (q[0] + q[1]) + (q[2] + q[3]); }
                        ss += __shfl_xor(ss, 16); ss += __shfl_xor(ss, 32);
                        const float f = rs * rsqrtf(ss * rs * rs * (1.0f / 32.0f) + EPS);
#pragma unroll
                        for (int n = 0; n < 2; ++n) { const f32x4 w = *(const GAS f32x4*)(wrp + 8 * fq + 4 * n);
                            const f32x4 cs = *(const GAS f32x4*)(cosT + (size_t)row * 16 + 8 * (fq & 1) + 4 * n), sn = *(const GAS f32x4*)(sinT + (size_t)row * 16 + 8 * (fq & 1) + 4 * n);
                            f32x4 o;
#pragma unroll
                            for (int e = 0; e < 4; ++e) { const float y = acc[ai][bj][m][n][e] * f * w[e]; const float pt = __shfl_xor(y, 32); o[e] = (y * cs[e] + sgn * pt * sn[e]) * c2; }
                            *(GAS u32x2*)(O + (size_t)row * ldo + (4 * bj + wc) * hw + 64 + 8 * fq + 4 * n) = (u32x2){cvt_pk_bf16(o[0], o[1]), cvt_pk_bf16(o[2], o[3])}; } }
                    asm volatile("" ::: "memory"); }
        }
    }
};
template <bool FIRST> struct EpiBranch { static constexpr bool PERM = true; bf16_t* O; const bf16_t* GL;
    __device__ __forceinline__ void operator()(const Acc& acc, const Unit& u, int wr, int wc, int fr, int fq) const {
        const int row0 = u.pm * BM + wr * 64 + fr, col0 = u.pn * BM + wc * 32 + 8 * fq;
#pragma unroll
        for (int ai = 0; ai < 2; ++ai)
#pragma unroll
            for (int m = 0; m < 4; ++m) { const size_t row = (size_t)(row0 + ai * HALF + m * 16);
#pragma unroll
                for (int bj = 0; bj < 2; ++bj) { const int c = col0 + bj * HALF;
                    const u32x4 gw = *(const GAS u32x4*)(GL + row * PROJ_LD + c);
                    f32x4 g0 = {bf_lo(gw.x), bf_hi(gw.x), bf_lo(gw.y), bf_hi(gw.y)}, g1 = {bf_lo(gw.z), bf_hi(gw.z), bf_lo(gw.w), bf_hi(gw.w)};
                    f32x4 o0, o1;
#pragma unroll
                    for (int e = 0; e < 4; ++e) { o0[e] = fast_sigmoid(g0[e]) * acc[ai][bj][m][0][e]; o1[e] = fast_sigmoid(g1[e]) * acc[ai][bj][m][1][e]; }
                    bf16_t* op = O + row * DM + c;
                    if (!FIRST) { const u32x4 ow = *(const GAS u32x4*)op;
                        o0 += (f32x4){bf_lo(ow.x), bf_hi(ow.x), bf_lo(ow.y), bf_hi(ow.y)}; o1 += (f32x4){bf_lo(ow.z), bf_hi(ow.z), bf_lo(ow.w), bf_hi(ow.w)}; }
                    *(GAS u32x4*)op = pack8(o0, o1); } }
    }
};
}

namespace att {
constexpr int KROW = 208, VROW = 144, KBUF = 64 * KROW, VBUF = 64 * VROW, V_OFF = 4 * KBUF;
constexpr float THR = 8.0f;
#define ATT_SB() __builtin_amdgcn_sched_barrier(0)
#define ATT_E(i) ((i) < 16 ? e0[(i) & 15] : e1[(i) & 15])
__device__ __forceinline__ float rowmax32(const f32x16& a, const f32x16& b) {
    float x = fmaxf(fmaxf(a[0], a[1]), b[0]), y = fmaxf(fmaxf(a[2], a[3]), b[1]); x = fmaxf(fmaxf(x, b[2]), b[3]);
#pragma unroll
    for (int r = 4; r < 16; r += 4) { x = fmaxf(fmaxf(x, a[r]), a[r + 1]); y = fmaxf(fmaxf(y, a[r + 2]), a[r + 3]); x = fmaxf(fmaxf(x, b[r]), b[r + 1]); y = fmaxf(fmaxf(y, b[r + 2]), b[r + 3]); }
    return fmaxf(x, y);
}
__device__ __forceinline__ void cmask(f32x16& p0, f32x16& p1, int kv0, int qidx, int hi) {
#pragma unroll
    for (int r = 0; r < 16; ++r) { const int kv = kv0 + (r & 3) + 8 * (r >> 2) + 4 * hi; if (kv > qidx) p0[r] = -INFINITY; if (kv + 32 > qidx) p1[r] = -INFINITY; }
}
template <int P> __device__ __forceinline__ void tile_iter(LAS unsigned char* lds, const int jt, const int NT, const int jmax, const int q0, const int qidx, const int hi,
        const unsigned ka, const unsigned va, const bf16_t* kn_src, const bf16_t* kr_src, const bf16_t* vt_src, const unsigned kn_dst, const unsigned kr_dst, const unsigned vt_dst, const bool has_r,
        const bf16x8 (&qr)[6], f32x16& o0, f32x16& o1, f32x16& negm, f32x16& s0, f32x16& s1, f32x16& e0, f32x16& e1, float& m_run, float& l_run,
        u32x4 (&gK)[2], u32x4 (&gR)[2], u32x4 (&gV)[2]) {
        { const unsigned nk = ((jt + 3) & 3) * KBUF, nv = ((jt + 2) & 3) * VBUF;
          *(LAS u32x4*)(lds + nk + kn_dst) = gK[P]; *(LAS u32x4*)(lds + nk + kr_dst) = gR[P];
          *(LAS u32x2*)(lds + nv + vt_dst) = (u32x2){gV[P].x, gV[P].y}; *(LAS u32x2*)(lds + nv + vt_dst + 16) = (u32x2){gV[P].z, gV[P].w};
          const int tk = (jt + 5 < NT) ? jt + 5 : NT - 1, tv = (jt + 4 < NT) ? jt + 4 : NT - 1;
          gK[P] = *(const GAS u32x4*)(kn_src + (size_t)tk * 64 * 512); gR[P] = *(const GAS u32x4*)(kr_src + (size_t)tk * 64 * 32); gV[P] = *(const GAS u32x4*)(vt_src + (size_t)tv * 64); }
        if (jt <= jmax) {
            const bool nx = jt + 1 <= jmax;
            const unsigned kb = ((jt + 1) & 3) * KBUF + ka, vb = (jt & 3) * VBUF + va;
            u32x4 pf[4]; float sacc = 0.f;
            {
                bf16x8 kf0 = *(const LAS bf16x8*)(lds + kb), kf1 = *(const LAS bf16x8*)(lds + kb + 32 * KROW), kn0 = kf0, kn1 = kf1;
                __builtin_amdgcn_s_setprio(1);
#pragma unroll
                for (int ks = 0; ks < 6; ++ks) {
                    if (ks < 5) { kn0 = *(const LAS bf16x8*)(lds + kb + (ks + 1) * 32); kn1 = *(const LAS bf16x8*)(lds + kb + 32 * KROW + (ks + 1) * 32); }
                    s0 = __builtin_amdgcn_mfma_f32_32x32x16_bf16(kf0, qr[ks], ks == 0 ? negm : s0, 0, 0, 0);
#pragma unroll
                    for (int i = (16 * ks) / 3; i < (16 * ks + 8) / 3; ++i) sacc += ATT_E(i);
#pragma unroll
                    for (int c = (8 * ks) / 3; c < (8 * ks + 4) / 3; ++c) pf[c >> 2][c & 3] = cvt_pk_bf16(ATT_E(2 * c), ATT_E(2 * c + 1));
                    ATT_SB();
                    s1 = __builtin_amdgcn_mfma_f32_32x32x16_bf16(kf1, qr[ks], ks == 0 ? negm : s1, 0, 0, 0);
#pragma unroll
                    for (int i = (16 * ks + 8) / 3; i < (16 * ks + 16) / 3; ++i) sacc += ATT_E(i);
#pragma unroll
                    for (int c = (8 * ks + 4) / 3; c < (8 * ks + 8) / 3; ++c) pf[c >> 2][c & 3] = cvt_pk_bf16(ATT_E(2 * c), ATT_E(2 * c + 1));
                    ATT_SB();
                    kf0 = kn0; kf1 = kn1;
                }
                __builtin_amdgcn_s_setprio(0);
            }
            l_run += sacc;
            float fsc = 1.0f; bool resc = false;
            if (nx) {
                const int kv0 = (jt + 1) * 64;
                if (kv0 + 63 > q0) cmask(s0, s1, kv0, qidx, hi);
                float rm = rowmax32(s0, s1);
                if (__any(rm > THR)) {
                    rm = fmaxf(rm, __shfl_xor(rm, 32));
                    const float dl = fmaxf(rm, 0.f);
                    m_run += dl; fsc = __builtin_amdgcn_exp2f(-dl); l_run *= fsc; resc = true;
#pragma unroll
                    for (int r = 0; r < 16; ++r) { s0[r] -= dl; s1[r] -= dl; negm[r] = -m_run; }
                }
            }
            ATT_SB();
            {
#define ATT_VA(m) (vb + ((m) & 1) * 32 * VROW + ((m) >> 1) * 32)
                bf16x8 vq[3];
                vq[0] = *(const LAS bf16x8*)(lds + ATT_VA(0)); vq[1] = *(const LAS bf16x8*)(lds + ATT_VA(1));
                __builtin_amdgcn_s_setprio(1);
#pragma unroll
                for (int m = 0; m < 8; ++m) {
                    if (m < 6) vq[(m + 2) % 3] = *(const LAS bf16x8*)(lds + ATT_VA(m + 2));
                    const bf16x8 vf = vq[m % 3];
                    const bf16x8 pb = __builtin_bit_cast(bf16x8, pf[m >> 1]);
                    if ((m & 1) == 0) o0 = __builtin_amdgcn_mfma_f32_32x32x16_bf16(vf, pb, o0, 0, 0, 0);
                    else o1 = __builtin_amdgcn_mfma_f32_32x32x16_bf16(vf, pb, o1, 0, 0, 0);
                    if (m < 4) {
#pragma unroll
                        for (int i = 4 * m; i < 4 * m + 4; ++i) e0[i] = __builtin_amdgcn_exp2f(s0[i]);
                        asm volatile("" : "+v"(e0));
                    } else {
#pragma unroll
                        for (int i = 4 * m - 16; i < 4 * m - 12; ++i) e1[i] = __builtin_amdgcn_exp2f(s1[i]);
                        asm volatile("" : "+v"(e1));
                    }
                    ATT_SB();
                }
                __builtin_amdgcn_s_setprio(0);
#undef ATT_VA
            }
            if (resc) {
#pragma unroll
                for (int r = 0; r < 16; ++r) { o0[r] *= fsc; o1[r] *= fsc; }
            }
        }
        if (P == 1) __syncthreads();
}
__device__ __forceinline__ void unit(LAS unsigned char* lds, int b, int h, int qb, const bf16_t* Q, const bf16_t* KN, const bf16_t* KR, const bf16_t* VT, bf16_t* O) {
    const int tid = opq_tid(), lane = tid & 63, wid = __builtin_amdgcn_readfirstlane(tid >> 6), r32 = lane & 31, hi = lane >> 5;
    const size_t tok0 = (size_t)b * SEQ;
    const int q0 = qb * 256 + wid * 32, qidx = q0 + r32, NT = 4 * (qb + 1), jmax = (q0 + 31) >> 6;
    bf16x8 qr[6];
    { const bf16_t* qp = Q + (tok0 + qidx) * QLD + h * 96 + hi * 8;
#pragma unroll
      for (int ks = 0; ks < 6; ++ks) qr[ks] = *(const GAS bf16x8*)(qp + ks * 16); }
    const int krow = tid >> 3, kch = tid & 7, rrow = (tid >> 2) & 63, rch = tid & 3;
    const bf16_t* kn_src = KN + (tok0 + krow) * 512 + h * 64 + kch * 8;
    const bf16_t* kr_src = KR + (tok0 + rrow) * 32 + rch * 8;
    const bf16_t* vt_src = VT + (size_t)(h * 64 + krow) * T + tok0 + kch * 8;
    const unsigned kn_dst = krow * KROW + kch * 16, kr_dst = rrow * KROW + 128 + rch * 16, vt_dst = V_OFF + krow * VROW + (kch >> 1) * 32 + (kch & 1) * 8;
    const bool has_r = tid < 256;
    u32x4 gk, gr = {0u, 0u, 0u, 0u}, gv;
    u32x4 gK[2], gR[2], gV[2];
    gK[0] = gr; gK[1] = gr; gR[0] = gr; gR[1] = gr; gV[0] = gr; gV[1] = gr;
    {
        gk = *(const GAS u32x4*)kn_src; gr = *(const GAS u32x4*)kr_src; gv = *(const GAS u32x4*)vt_src;
        const u32x4 gk1 = *(const GAS u32x4*)(kn_src + (size_t)64 * 512), gr1 = *(const GAS u32x4*)(kr_src + (size_t)64 * 32), gv1 = *(const GAS u32x4*)(vt_src + 64);
        const u32x4 gk2 = *(const GAS u32x4*)(kn_src + (size_t)2 * 64 * 512), gr2 = *(const GAS u32x4*)(kr_src + (size_t)2 * 64 * 32);
        gK[0] = *(const GAS u32x4*)(kn_src + (size_t)3 * 64 * 512); gR[0] = *(const GAS u32x4*)(kr_src + (size_t)3 * 64 * 32); gV[0] = *(const GAS u32x4*)(vt_src + (size_t)2 * 64);
        { const int t4 = NT > 4 ? 4 : 3; gK[1] = *(const GAS u32x4*)(kn_src + (size_t)t4 * 64 * 512); gR[1] = *(const GAS u32x4*)(kr_src + (size_t)t4 * 64 * 32); gV[1] = *(const GAS u32x4*)(vt_src + (size_t)3 * 64); }
        *(LAS u32x4*)(lds + kn_dst) = gk; *(LAS u32x4*)(lds + kr_dst) = gr;
        *(LAS u32x2*)(lds + vt_dst) = (u32x2){gv.x, gv.y}; *(LAS u32x2*)(lds + vt_dst + 16) = (u32x2){gv.z, gv.w};
        *(LAS u32x4*)(lds + KBUF + kn_dst) = gk1; *(LAS u32x4*)(lds + KBUF + kr_dst) = gr1;
        *(LAS u32x2*)(lds + VBUF + vt_dst) = (u32x2){gv1.x, gv1.y}; *(LAS u32x2*)(lds + VBUF + vt_dst + 16) = (u32x2){gv1.z, gv1.w};
        *(LAS u32x4*)(lds + 2 * KBUF + kn_dst) = gk2; *(LAS u32x4*)(lds + 2 * KBUF + kr_dst) = gr2;
    }
    __syncthreads();
    const unsigned ka = r32 * KROW + hi * 16;
    const unsigned va = V_OFF + r32 * VROW + hi * 16;
    f32x16 o0, o1, negm, s0, s1, e0, e1;
#pragma unroll
    for (int r = 0; r < 16; ++r) { o0[r] = 0.f; o1[r] = 0.f; s0[r] = 0.f; s1[r] = 0.f; }
    float m_run, l_run = 0.f;
    {
#pragma unroll
        for (int ks = 0; ks < 6; ++ks) {
            const bf16x8 k0 = *(const LAS bf16x8*)(lds + ka + ks * 32), k1 = *(const LAS bf16x8*)(lds + ka + 32 * KROW + ks * 32);
            s0 = __builtin_amdgcn_mfma_f32_32x32x16_bf16(k0, qr[ks], s0, 0, 0, 0);
            s1 = __builtin_amdgcn_mfma_f32_32x32x16_bf16(k1, qr[ks], s1, 0, 0, 0);
        }
        if (63 > q0) cmask(s0, s1, 0, qidx, hi);
        float rm = rowmax32(s0, s1); rm = fmaxf(rm, __shfl_xor(rm, 32));
        m_run = rm;
#pragma unroll
        for (int r = 0; r < 16; ++r) { e0[r] = __builtin_amdgcn_exp2f(s0[r] - rm); e1[r] = __builtin_amdgcn_exp2f(s1[r] - rm); negm[r] = -rm; }
    }
    __syncthreads();
    for (int jt = 0; jt < NT; jt += 2) {
        tile_iter<0>(lds, jt, NT, jmax, q0, qidx, hi, ka, va, kn_src, kr_src, vt_src, kn_dst, kr_dst, vt_dst, has_r, qr, o0, o1, negm, s0, s1, e0, e1, m_run, l_run, gK, gR, gV);
        tile_iter<1>(lds, jt + 1, NT, jmax, q0, qidx, hi, ka, va, kn_src, kr_src, vt_src, kn_dst, kr_dst, vt_dst, has_r, qr, o0, o1, negm, s0, s1, e0, e1, m_run, l_run, gK, gR, gV);
    }
    const float lt = l_run + __shfl_xor(l_run, 32);
    const float inv = 1.0f / lt;
    bf16_t* op = O + (tok0 + qidx) * 512 + h * 64 + 4 * hi;
#pragma unroll
    for (int g = 0; g < 4; ++g) {
        *(GAS u32x2*)(op + 8 * g) = (u32x2){cvt_pk_bf16(o0[4 * g] * inv, o0[4 * g + 1] * inv), cvt_pk_bf16(o0[4 * g + 2] * inv, o0[4 * g + 3] * inv)};
        *(GAS u32x2*)(op + 32 + 8 * g) = (u32x2){cvt_pk_bf16(o1[4 * g] * inv, o1[4 * g + 1] * inv), cvt_pk_bf16(o1[4 * g + 2] * inv, o1[4 * g + 3] * inv)};
    }
}
__device__ __forceinline__ void phase(LAS unsigned char* lds, const bf16_t* Q, const bf16_t* KN, const bf16_t* KR, const bf16_t* VT, bf16_t* O) {
    for (int j = blockIdx.x; j < 2048; j += gridDim.x) {
        const int bh = j & 63, qslot = j >> 6, k = qslot >> 2, s = qslot & 3, i = k >> 1;
        const int qb = (k & 1) ? 31 - (4 * i + s) : 4 * i + s;
        unit(lds, bh >> 3, bh & 7, qb, Q, KN, KR, VT, O);
    }
}
#undef ATT_SB
#undef ATT_E
}

__device__ __forceinline__ int src_col(int map, int n0) {
    const int pn = n0 >> 8, bj = (n0 >> 7) & 1, wc = (n0 >> 5) & 3;
    switch (map) {
        case 1: return bj * FF + 128 * pn + (n0 & 127);
        case 2: return pn < 2 ? 96 * (4 * pn + wc) + 32 * bj : 96 * (4 * bj + wc) + 64;
        case 3: return 128 * (4 * pn + wc) + 32 * bj;
        case 4: return 128 * (n0 >> 6) + 64 + (n0 & 63);
        case 5: return n0 < 4000 ? n0 : -1;
        default: return n0;
    }
}
__device__ __forceinline__ void tr_item(const float* W, int K, int pitch, bf16_t* WT, const float* scale, int map, int nblk, LAS float* scr, int item, int lane) {
    const int kb = item / nblk, nb = item % nblk, k0 = 64 * kb, n0 = 32 * nb;
    const int sc0 = src_col(map, n0);
#pragma unroll 8
    for (int i = 0; i < 32; ++i) { const int kk = 2 * i + (lane >> 5); float v = 0.f;
        if (sc0 >= 0) { v = ((const GAS float*)W)[(size_t)(k0 + kk) * pitch + sc0 + (lane & 31)]; if (scale) v *= ((const GAS float*)scale)[k0 + kk]; }
        scr[kk * 33 + (lane & 31)] = v; }
    asm volatile("s_waitcnt lgkmcnt(0)" ::: "memory");
    const int c = lane & 7;
#pragma unroll
    for (int j = 0; j < 4; ++j) { const int n = (lane >> 3) + 8 * j; const LAS float* s = scr + (8 * c) * 33 + n;
        u32x4 o; o.x = cvt_pk_bf16(s[0 * 33], s[1 * 33]); o.y = cvt_pk_bf16(s[2 * 33], s[3 * 33]); o.z = cvt_pk_bf16(s[4 * 33], s[5 * 33]); o.w = cvt_pk_bf16(s[6 * 33], s[7 * 33]);
        *(GAS u32x4*)(WT + (size_t)(n0 + n) * K + k0 + 8 * c) = o; }
    asm volatile("s_waitcnt lgkmcnt(0)" ::: "memory");
}

struct Args { const void* in[20]; float* out; unsigned char* ws; int ph_lo, ph_hi; };

__device__ __forceinline__ void gemv64(const LAS float* sc, LAS float* red, const float* W, int pitch, int n0, int nvalid, const float* bias, float* out, int ldo, int tid) {
    const int lane = tid & 63, wid = tid >> 6, n = n0 + lane; const bool valid = n < nvalid;
    const GAS float* Wg = (const GAS float*)W + (valid ? n : 0);
    float acc[8];
#pragma unroll
    for (int b = 0; b < 8; ++b) acc[b] = 0.f;
#pragma unroll 16
    for (int kk = 0; kk < 128; ++kk) { const int k = wid * 128 + kk; const float w = Wg[(size_t)k * pitch];
#pragma unroll
        for (int b = 0; b < 8; ++b) acc[b] += sc[b * 1024 + k] * w; }
#pragma unroll
    for (int b = 0; b < 8; ++b) red[(wid * 8 + b) * 64 + lane] = acc[b];
    __syncthreads();
    { float sum = (bias && valid) ? ((const GAS float*)bias)[n] : 0.f;
#pragma unroll
      for (int w = 0; w < 8; ++w) sum += red[(w * 8 + wid) * 64 + lane];
      ((GAS float*)out)[(size_t)wid * ldo + n] = valid ? sum : 0.f; }
    __syncthreads();
}
__device__ __forceinline__ void xa_phase(const Args& A, LAS unsigned char* lds) {
    const int tid = opq_tid(), lane = tid & 63, wid = tid >> 6;
    unsigned char* ws = opq(A.ws);
    const float* mod = (const float*)(ws + WS_MOD);
    const float* normw = (const float*)A.in[5];
    {
        LAS float* sc = (LAS float*)lds; LAS float* red = (LAS float*)(lds + 32768);
        for (int it = blockIdx.x; it < 240; it += gridDim.x) {
            int sub, g; const float* W; int pitch, nvalid, ldo; float* out;
            if (it < 88) { sub = 0; g = it; W = (const float*)A.in[6]; pitch = 2 * FF; nvalid = 2 * FF; ldo = 2 * FF; out = (float*)(ws + WS_SHW0); }
            else if (it < 152) { sub = 1; g = it - 88; W = (const float*)A.in[8]; pitch = 4000; nvalid = 4000; ldo = PROJ_LD; out = (float*)(ws + WS_SHW1); }
            else { sub = 2; g = it - 152; W = (const float*)A.in[6] + (size_t)DM * 2 * FF; pitch = 2 * FF; nvalid = 2 * FF; ldo = 2 * FF; out = (float*)(ws + WS_SHW2); }
            for (int i = tid; i < 8192; i += 512) sc[i] = ((const GAS float*)mod)[(size_t)(i >> 10) * MODLD + sub * 3072 + (i & 1023)];
            __syncthreads();
            gemv64(sc, red, W, pitch, g * 64, nvalid, nullptr, out, ldo, tid);
        }
        if ((int)blockIdx.x == (int)gridDim.x - 1) {
            float* av = (float*)(ws + WS_AVEC);
            for (int i = tid; i < 2 * 8 * 1024; i += 512) { const int sb = i >> 13, b = (i >> 10) & 7, c = i & 1023;
                ((GAS float*)av)[i] = ((const GAS float*)normw)[(sb + 1) * 1024 + c] * (1.0f + ((const GAS float*)mod)[(size_t)b * MODLD + (sb + 1) * 3072 + 1024 + c]); }
        }
    }
    const float* X = (const float*)A.in[0]; bf16_t* XA = (bf16_t*)(ws + WS_H); float* ssp = (float*)(ws + WS_SSP);
    const int gw = blockIdx.x * 8 + wid, NGW = gridDim.x * 8;
    for (int ch = gw; ch < T / 32; ch += NGW) {
        const int row0 = ch * 32, b = row0 / SEQ;
        const float* scp = mod + (size_t)b * MODLD + 1024;
        f32x4 a[4];
#pragma unroll
        for (int j = 0; j < 4; ++j) { const int c = 4 * lane + 256 * j; a[j] = *(const GAS f32x4*)(normw + c) * (*(const GAS f32x4*)(scp + c) + 1.0f); }
        f32x4 vn[4];
        { const float* xr = X + (size_t)row0 * DM + 4 * lane;
#pragma unroll
          for (int j = 0; j < 4; ++j) vn[j] = *(const GAS f32x4*)(xr + 256 * j); }
        for (int r = 0; r < 32; ++r) {
            f32x4 v[4]; float ss = 0.f;
#pragma unroll
            for (int j = 0; j < 4; ++j) v[j] = vn[j];
            if (r < 31) { const float* xr = X + (size_t)(row0 + r + 1) * DM + 4 * lane;
#pragma unroll
                for (int j = 0; j < 4; ++j) vn[j] = *(const GAS f32x4*)(xr + 256 * j); }
#pragma unroll
            for (int j = 0; j < 4; ++j) { const f32x4 q = v[j] * v[j]; ss += (q[0] + q[1]) + (q[2] + q[3]); }
            ss = wave_sum(ss);
            bf16_t* hr = XA + (size_t)(row0 + r) * DM + 4 * lane;
#pragma unroll
            for (int j = 0; j < 4; ++j) { const f32x4 o = v[j] * a[j]; *(GAS u32x2*)(hr + 256 * j) = (u32x2){cvt_pk_bf16(o[0], o[1]), cvt_pk_bf16(o[2], o[3])}; }
            if (lane < 16) ((GAS float*)ssp)[(size_t)(row0 + r) * 16 + lane] = lane == 0 ? ss : 0.f;
        }
    }
}

__device__ __forceinline__ void unpack8(const u32x4 w, float (&f)[8]) { f[0] = bf_lo(w.x); f[1] = bf_hi(w.x); f[2] = bf_lo(w.y); f[3] = bf_hi(w.y); f[4] = bf_lo(w.z); f[5] = bf_hi(w.z); f[6] = bf_lo(w.w); f[7] = bf_hi(w.w); }

__device__ __forceinline__ void conv_phase(const bf16_t* P, const float* convw, const float* krw, const float* cosT, const float* sinT, float* rstdq, float* rstdkv, bf16_t* KR, bf16_t* OC) {
    const int tid = opq_tid(), lane = tid & 63, gw = blockIdx.x * 8 + (tid >> 6), NGW = gridDim.x * 8;
    float w0[8], w1[8], w2[8];
#pragma unroll
    for (int e = 0; e < 8; ++e) { w0[e] = convw[8 * lane + e]; w1[e] = convw[512 + 8 * lane + e]; w2[e] = convw[1024 + 8 * lane + e]; }
    const int kl = (lane - 48) & 3;
    float kw[8];
#pragma unroll
    for (int e = 0; e < 8; ++e) kw[e] = krw[8 * kl + e];
    for (int ch = gw; ch < T / 32; ch += NGW) {
        const int row0 = ch * 32, s0 = row0 % SEQ;
        float um2[8], um1[8];
#pragma unroll
        for (int e = 0; e < 8; ++e) { um2[e] = 0.f; um1[e] = 0.f; }
        if (s0 > 0) {
            float a[8], c[8];
            unpack8(*(const GAS u32x4*)(P + (size_t)(row0 - 2) * PROJ_LD + C_CONV + 8 * lane), a); unpack8(*(const GAS u32x4*)(P + (size_t)(row0 - 2) * PROJ_LD + C_GC + 8 * lane), c);
#pragma unroll
            for (int e = 0; e < 8; ++e) um2[e] = a[e] * c[e];
            unpack8(*(const GAS u32x4*)(P + (size_t)(row0 - 1) * PROJ_LD + C_CONV + 8 * lane), a); unpack8(*(const GAS u32x4*)(P + (size_t)(row0 - 1) * PROJ_LD + C_GC + 8 * lane), c);
#pragma unroll
            for (int e = 0; e < 8; ++e) um1[e] = a[e] * c[e];
        }
        u32x4 nxv, ngb, ngc, nst = {0u, 0u, 0u, 0u};
        { const bf16_t* pr = P + (size_t)row0 * PROJ_LD;
          nxv = *(const GAS u32x4*)(pr + C_CONV + 8 * lane); ngb = *(const GAS u32x4*)(pr + C_GB + 8 * lane); ngc = *(const GAS u32x4*)(pr + C_GC + 8 * lane);
          if (lane < 52) nst = *(const GAS u32x4*)(pr + 8 * lane); }
        for (int r = 0; r < 32; ++r) {
            const size_t row = (size_t)(row0 + r);
            float xv[8], gb[8], gc[8], st[8];
            unpack8(nxv, xv); unpack8(ngb, gb); unpack8(ngc, gc); unpack8(nst, st);
            if (r < 31) { const bf16_t* pr = P + (row + 1) * PROJ_LD;
                nxv = *(const GAS u32x4*)(pr + C_CONV + 8 * lane); ngb = *(const GAS u32x4*)(pr + C_GB + 8 * lane); ngc = *(const GAS u32x4*)(pr + C_GC + 8 * lane);
                if (lane < 52) nst = *(const GAS u32x4*)(pr + 8 * lane); }
            float o[8];
#pragma unroll
            for (int e = 0; e < 8; ++e) { const float u = gc[e] * xv[e]; o[e] = gb[e] * (w0[e] * um2[e] + w1[e] * um1[e] + w2[e] * u); um2[e] = um1[e]; um1[e] = u; }
            *(GAS u32x4*)(OC + row * 512 + 8 * lane) = (u32x4){cvt_pk_bf16(o[0], o[1]), cvt_pk_bf16(o[2], o[3]), cvt_pk_bf16(o[4], o[5]), cvt_pk_bf16(o[6], o[7])};
            float ss = 0.f;
#pragma unroll
            for (int e = 0; e < 8; ++e) ss += st[e] * st[e];
            const float sq = wave_sum(lane < 32 ? ss : 0.f), skv = wave_sum((lane >= 32 && lane < 48) ? ss : 0.f), skr = wave_sum((lane >= 48 && lane < 52) ? ss : 0.f);
            { const float rn = lane < 32 ? rsqrtf(sq * (1.0f / 256.0f) + EPS) : rsqrtf(skv * (1.0f / 128.0f) + EPS);
              if (lane < 48) *(GAS u32x4*)((bf16_t*)P + row * PROJ_LD + 8 * lane) = (u32x4){cvt_pk_bf16(st[0] * rn, st[1] * rn), cvt_pk_bf16(st[2] * rn, st[3] * rn), cvt_pk_bf16(st[4] * rn, st[5] * rn), cvt_pk_bf16(st[6] * rn, st[7] * rn)}; }
            const float rk = rsqrtf(skr * (1.0f / 32.0f) + EPS);
            const f32x4 c0 = *(const GAS f32x4*)(cosT + row * 16 + 8 * (kl & 1)), c1 = *(const GAS f32x4*)(cosT + row * 16 + 8 * (kl & 1) + 4);
            const f32x4 s0v = *(const GAS f32x4*)(sinT + row * 16 + 8 * (kl & 1)), s1v = *(const GAS f32x4*)(sinT + row * 16 + 8 * (kl & 1) + 4);
            const float sgn = (kl < 2) ? -1.0f : 1.0f;
            float ko[8];
#pragma unroll
            for (int e = 0; e < 8; ++e) { const float y = st[e] * rk * kw[e]; const float pt = __shfl_xor(y, 2);
                const float cc = e < 4 ? c0[e & 3] : c1[e & 3], sn = e < 4 ? s0v[e & 3] : s1v[e & 3]; ko[e] = y * cc + sgn * pt * sn; }
            if (lane >= 48 && lane < 52) *(GAS u32x4*)(KR + row * 32 + 8 * kl) = (u32x4){cvt_pk_bf16(ko[0], ko[1]), cvt_pk_bf16(ko[2], ko[3]), cvt_pk_bf16(ko[4], ko[5]), cvt_pk_bf16(ko[6], ko[7])};
        }
    }
}

__device__ const float INV_FREQ[16] = {1.0f, 0.5623413324356079f, 0.3162277638912201f, 0.17782793939113617f, 0.10000000149011612f, 0.05623412877321243f, 0.03162277862429619f, 0.017782794311642647f,
    0.009999999776482582f, 0.005623413249850273f, 0.003162277862429619f, 0.0017782794311642647f, 0.0010000000474974513f, 0.000562341301701963f, 0.0003162277862429619f, 0.00017782794020604342f};

__device__ __forceinline__ void sincos_reduced(float ang, float& s, float& c) {
    const double x = (double)ang;
    const double k = __builtin_rint(x * 0.15915494309189535);
    const float r = (float)(x - k * 6.283185307179586);
    s = __sinf(r); c = __cosf(r);
}

__device__ __forceinline__ void prologue(const Args& A, LAS unsigned char* lds) {
    const int tid = opq_tid(), lane = tid & 63, wid = tid >> 6;
    unsigned char* ws = opq(A.ws);
    {
        LAS float* sc = (LAS float*)lds; LAS float* red = (LAS float*)(lds + 32768);
        const float* c = (const float*)A.in[1];
        if ((int)blockIdx.x < 144) {
            for (int i = tid; i < 8192; i += 512) { const float v = ((const GAS float*)c)[i]; sc[i] = v / (1.0f + __expf(-v)); }
            __syncthreads();
        }
        for (int cgp = blockIdx.x; cgp < 144; cgp += gridDim.x)
            gemv64(sc, red, (const float*)A.in[3], MODLD, cgp * 64, MODLD, (const float*)A.in[4], (float*)(ws + WS_MOD), MODLD, tid);
    }
    __syncthreads();
    {
        const int* pos = (const int*)A.in[2]; float* cosT = (float*)(ws + WS_COS); float* sinT = (float*)(ws + WS_SIN);
        for (int idx = blockIdx.x * 512 + tid; idx < T * 16; idx += gridDim.x * 512) {
            const float ang = (float)((const GAS int*)pos)[idx >> 4] * INV_FREQ[idx & 15]; float s, c; sincos_reduced(ang, s, c); ((GAS float*)cosT)[idx] = c; ((GAS float*)sinT)[idx] = s; }
    }
    {
        LAS float* scr = (LAS float*)(lds + wid * 16384);
        const int gw = blockIdx.x * 8 + wid, NGW = gridDim.x * 8;
        const float* w13 = (const float*)A.in[6]; const float* w2 = (const float*)A.in[7]; const float* win = (const float*)A.in[8];
        const float* qan = (const float*)A.in[9]; const float* wuq = (const float*)A.in[10]; const float* kvan = (const float*)A.in[11]; const float* wukv = (const float*)A.in[12];
        const float* wbr = (const float*)A.in[18]; const float* wout = (const float*)A.in[19];
        constexpr int I13 = 16 * 176, I2 = 44 * 32, IIN = 16 * 128, IUQ = 4 * 24, IUK = 2 * 16, IV = 2 * 16, IB = 8 * 32, IO = 16 * 32;
        constexpr int NIT = 2 * I13 + 2 * I2 + IIN + IUQ + IUK + IV + 2 * IB + IO;
        for (int it = gw; it < NIT; it += NGW) {
            int r = it;
            if (r < I13) { tr_item(w13, 1024, 5632, (bf16_t*)(ws + WS_W13A), nullptr, 1, 176, scr, r, lane); continue; } r -= I13;
            if (r < I13) { tr_item(w13 + (size_t)1024 * 5632, 1024, 5632, (bf16_t*)(ws + WS_W13B), nullptr, 1, 176, scr, r, lane); continue; } r -= I13;
            if (r < I2) { tr_item(w2, 2816, 1024, (bf16_t*)(ws + WS_W2A), nullptr, 0, 32, scr, r, lane); continue; } r -= I2;
            if (r < I2) { tr_item(w2 + (size_t)2816 * 1024, 2816, 1024, (bf16_t*)(ws + WS_W2B), nullptr, 0, 32, scr, r, lane); continue; } r -= I2;
            if (r < IIN) { tr_item(win, 1024, 4000, (bf16_t*)(ws + WS_WIN), nullptr, 5, 128, scr, r, lane); continue; } r -= IIN;
            if (r < IUQ) { tr_item(wuq, 256, 768, (bf16_t*)(ws + WS_WUQ), qan, 2, 24, scr, r, lane); continue; } r -= IUQ;
            if (r < IUK) { tr_item(wukv, 128, 1024, (bf16_t*)(ws + WS_WUK), kvan, 3, 16, scr, r, lane); continue; } r -= IUK;
            if (r < IV) { tr_item(wukv, 128, 1024, (bf16_t*)(ws + WS_WV), kvan, 4, 16, scr, r, lane); continue; } r -= IV;
            if (r < IB) { tr_item(wbr, 512, 1024, (bf16_t*)(ws + WS_WB0), nullptr, 0, 32, scr, r, lane); continue; } r -= IB;
            if (r < IB) { tr_item(wbr + (size_t)512 * 1024, 512, 1024, (bf16_t*)(ws + WS_WB1), nullptr, 0, 32, scr, r, lane); continue; } r -= IB;
            tr_item(wout, 1024, 1024, (bf16_t*)(ws + WS_WOUT), nullptr, 0, 32, scr, r, lane);
        }
    }
    __syncthreads();
}

#define XB_TMO      128
#define XB_XCNT(j)  (256  + 64 * (j))
#define XB_XSUB(j)  (1280 + 64 * (j))
#define XB_XGEN(j)  (2304 + 64 * (j))
#define XB_TOP      3328
#define XB_TOPGEN   3392
#define XCD_BAR_WORDS 3456
#define XB_SPIN_CAP (1u << 22)
__device__ __forceinline__ unsigned xb_ld(unsigned* p)              { return __hip_atomic_load(p, __ATOMIC_RELAXED, __HIP_MEMORY_SCOPE_AGENT); }
__device__ __forceinline__ unsigned xb_add(unsigned* p, unsigned v) { return __hip_atomic_fetch_add(p, v, __ATOMIC_RELAXED, __HIP_MEMORY_SCOPE_AGENT); }
__device__ __forceinline__ unsigned xb_xcc_id() { return (unsigned)__builtin_amdgcn_s_getreg((3 << 11) | 20) & 0xFu; }
#define XB_SPIN(cond, bar) do { unsigned _sp = 0; while (cond) { __builtin_amdgcn_s_sleep(1); \
    if ((++_sp & 255u) == 0u) { if (xb_ld(&(bar)[XB_TMO])) break; if (_sp > XB_SPIN_CAP) { atomicAdd(&(bar)[XB_TMO], 1u); break; } } } } while (0)
struct XcdBarrier { unsigned* bar; unsigned x; volatile LAS unsigned* st; };
__device__ __forceinline__ XcdBarrier xcd_barrier_post(unsigned* bar, volatile LAS unsigned* st, int tid) {
    XcdBarrier b; b.bar = bar; b.x = xb_xcc_id(); b.st = st;
    if (tid == 0) (void)xb_add(&bar[XB_XCNT(b.x)], 1u);
    return b;
}
__device__ __forceinline__ void xcd_barrier_complete(unsigned* bar, unsigned x, unsigned& nloc, unsigned& nx) {
    const unsigned G = gridDim.x;
    unsigned sum, cnt, mine, sp = 0u;
    for (;;) {
        sum = 0u; cnt = 0u; mine = 0u;
#pragma unroll
        for (unsigned j = 0; j < 16; ++j) { const unsigned c = xb_ld(&bar[XB_XCNT(j)]); sum += c; cnt += (c > 0u) ? 1u : 0u; mine = (j == x) ? c : mine; }
        if (sum == G) break;
        __builtin_amdgcn_s_sleep(1);
        if ((++sp & 255u) == 0u) { if (xb_ld(&bar[XB_TMO])) break; if (sp > XB_SPIN_CAP) { atomicAdd(&bar[XB_TMO], 1u); break; } }
    }
    nloc = mine > 0u ? mine : 1u; nx = cnt > 0u ? cnt : 1u;
}
__device__ __forceinline__ void xcd_barrier(const XcdBarrier& b) {
    asm volatile("s_waitcnt vmcnt(0)" ::: "memory");
    __syncthreads();
    if (opq_tid() == 0) {
        unsigned* bar = b.bar;
        __builtin_amdgcn_s_waitcnt(0);
        unsigned nloc = b.st[0], nx = b.st[1];
        if (nloc == 0u) { xcd_barrier_complete(bar, b.x, nloc, nx); b.st[0] = nloc; b.st[1] = nx; }
        const unsigned old = xb_add(&bar[XB_XSUB(b.x)], 1u);
        const unsigned gen = old / nloc;
        if (old + 1u == (gen + 1u) * nloc) {
            __builtin_amdgcn_fence(__ATOMIC_RELEASE, "agent");
            asm volatile("s_waitcnt vmcnt(0)" ::: "memory");
            const unsigned og = xb_add(&bar[XB_TOP], 1u);
            const unsigned tg = og / nx;
            if (og + 1u == (tg + 1u) * nx) xb_add(&bar[XB_TOPGEN], 1u);
            else XB_SPIN(xb_ld(&bar[XB_TOPGEN]) == tg, bar);
            __builtin_amdgcn_fence(__ATOMIC_ACQUIRE, "agent");
            xb_add(&bar[XB_XGEN(b.x)], 1u);
            asm volatile("s_waitcnt vmcnt(0)" ::: "memory");
        } else {
            XB_SPIN(xb_ld(&bar[XB_XGEN(b.x)]) == gen, bar);
            __builtin_amdgcn_fence(__ATOMIC_ACQUIRE, "agent");
            asm volatile("s_waitcnt vmcnt(0)" ::: "memory");
        }
    }
    __syncthreads();
}

#ifndef MK_PER_PHASE
#define MK_PER_PHASE 0
#endif
__global__ void __launch_bounds__(512) fwd_kernel(Args A) {
    extern __shared__ __attribute__((aligned(16))) unsigned char lds_raw[];
    LAS unsigned char* lds = (LAS unsigned char*)lds_raw;
    cg::grid_group grid = cg::this_grid();
    const int G = gridDim.x, cidx = blockIdx.x;
    { const int t0 = opq_tid(); if (t0 < 32) ((LAS unsigned*)(lds + LDS_MISC))[t0] = 0u; __syncthreads(); }
    if (blockIdx.x == 0) { GAS u32x4* bz = (GAS u32x4*)(opq(A.ws) + WS_BAR); const int t0 = opq_tid(); bz[t0] = (u32x4){0u, 0u, 0u, 0u}; bz[512 + t0] = (u32x4){0u, 0u, 0u, 0u}; }
    const int lo = A.ph_lo, hi = A.ph_hi; (void)lo; (void)hi;
#if MK_PER_PHASE
#define IN(k) (lo <= (k) && (k) < hi)
#define SEAM(k) do { } while (0)
#else
#define IN(k) true
#define SEAM(k) do { if ((k) == 0) grid.sync(); else { XcdBarrier xb_; xb_.bar = (unsigned*)(opq(A.ws) + WS_BAR); xb_.x = xb_xcc_id(); xb_.st = (volatile LAS unsigned*)(lds + LDS_MISC); xcd_barrier(xb_); } } while (0)
#endif
#define WSP(T_, off) ((T_*)(ws + (off)))
#ifndef DUP
#define DUP 0
#endif
#if DUP
#define REP(k) for (int rep_ = 0; rep_ <= ((DUP >> (k)) & 1); ++rep_)
#else
#define REP(k)
#endif
    using namespace pg8;

    REP(0) { if (IN(0)) { prologue(A, lds); } SEAM(0); }
    (void)xcd_barrier_post((unsigned*)(opq(A.ws) + WS_BAR), (volatile LAS unsigned*)(lds + LDS_MISC), opq_tid());
    REP(1) { if (IN(1)) { xa_phase(A, lds); } SEAM(1); }
    REP(2) { if (IN(2)) { unsigned char* ws = opq(A.ws); Gemm g{WSP(const bf16_t, WS_H), WSP(const bf16_t, WS_W13A), T, 2 * FF, DM, DM, DM}; StaticOrder S; S.init(T, 2 * FF, G, cidx);
        EpiSwiGLU E{WSP(bf16_t, WS_BIG), WSP(const float, WS_SSP), WSP(const float, WS_SHW0)}; gemm_phase<EpiSwiGLU, StaticOrder, true>(lds, g, S, E); } SEAM(2); }
    REP(3) { if (IN(3)) { unsigned char* ws = opq(A.ws); Gemm g{WSP(const bf16_t, WS_BIG), WSP(const bf16_t, WS_W2A), T, DM, FF, FF, FF}; StaticOrder S; S.init(T, DM, G, cidx);
        EpiResidN<0> E{opq((const float*)A.in[0]), opq(A.out), WSP(bf16_t, WS_H), WSP(float, WS_SSP), WSP(const float, WS_MOD) + 0 * 3072 + 2048, WSP(const float, WS_AVEC), 0.5f};
        gemm_phase<EpiResidN<0>, StaticOrder, true>(lds, g, S, E); } SEAM(3); }
    REP(5) { if (IN(5)) { unsigned char* ws = opq(A.ws); Gemm g{WSP(const bf16_t, WS_H), WSP(const bf16_t, WS_WIN), T, PROJ_LD, DM, DM, DM}; StaticOrder S; S.init(T, PROJ_LD, G, cidx);
        EpiProj E{WSP(bf16_t, WS_BIG), WSP(const float, WS_SSP), WSP(const float, WS_SHW1)}; gemm_phase<EpiProj, StaticOrder, true>(lds, g, S, E); } SEAM(5); }
    REP(6) { if (IN(6)) { unsigned char* ws = opq(A.ws); conv_phase(WSP(const bf16_t, WS_BIG), (const float*)A.in[17], (const float*)A.in[16], WSP(const float, WS_COS), WSP(const float, WS_SIN),
        WSP(float, WS_RSTDQ), WSP(float, WS_RSTDKV), WSP(bf16_t, WS_KR), WSP(bf16_t, WS_OCONV)); } SEAM(6); }
    REP(7) { if (IN(7)) {
        { unsigned char* ws = opq(A.ws); Gemm g{WSP(const bf16_t, WS_BIG), WSP(const bf16_t, WS_WUQ), T, 768, 256, PROJ_LD, 256}; StaticOrder S; S.init(T, 768, G, cidx);
          EpiQK<2> E{WSP(bf16_t, WS_Q), QLD, 96, WSP(const float, WS_RSTDQ), (const float*)A.in[13], (const float*)A.in[15], WSP(const float, WS_COS), WSP(const float, WS_SIN), QSCALE};
          gemm_phase<EpiQK<2>, StaticOrder, true>(lds, g, S, E); }
        { unsigned char* ws = opq(A.ws); Gemm g{WSP(const bf16_t, WS_BIG) + 256, WSP(const bf16_t, WS_WUK), T, 512, 128, PROJ_LD, 128}; StaticOrder S; S.init(T, 512, G, cidx);
          EpiQK<-1> E{WSP(bf16_t, WS_KN), 512, 64, WSP(const float, WS_RSTDKV), (const float*)A.in[14], nullptr, nullptr, nullptr, 1.0f};
          gemm_phase<EpiQK<-1>, StaticOrder, true>(lds, g, S, E); }
        { unsigned char* ws = opq(A.ws); Gemm g{WSP(const bf16_t, WS_WV), WSP(const bf16_t, WS_BIG) + 256, 512, T, 128, 128, PROJ_LD}; StaticOrder S; S.init(512, T, G, cidx);
          EpiVT E{WSP(bf16_t, WS_VT), WSP(const float, WS_RSTDKV)}; gemm_phase<EpiVT, StaticOrder, true>(lds, g, S, E); }
    } SEAM(7); }
    REP(8) { if (IN(8)) { unsigned char* ws = opq(A.ws); att::phase(lds, WSP(const bf16_t, WS_Q), WSP(const bf16_t, WS_KN), WSP(const bf16_t, WS_KR), WSP(const bf16_t, WS_VT), WSP(bf16_t, WS_OATT)); } SEAM(8); }
    REP(9) { if (IN(9)) {
        { unsigned char* ws = opq(A.ws); Gemm g{WSP(const bf16_t, WS_OATT), WSP(const bf16_t, WS_WB0), T, DM, 512, 512, 512}; StaticOrder S; S.init(T, DM, G, cidx);
          EpiBranch<true> E{WSP(bf16_t, WS_MERGED), WSP(const bf16_t, WS_BIG) + C_GL}; gemm_phase<EpiBranch<true>, StaticOrder, true>(lds, g, S, E); }
        { unsigned char* ws = opq(A.ws); Gemm g{WSP(const bf16_t, WS_OCONV), WSP(const bf16_t, WS_WB1), T, DM, 512, 512, 512}; StaticOrder S; S.init(T, DM, G, cidx);
          EpiBranch<false> E{WSP(bf16_t, WS_MERGED), WSP(const bf16_t, WS_BIG) + C_GL + 1024}; gemm_phase<EpiBranch<false>, StaticOrder, true>(lds, g, S, E); }
    } SEAM(9); }
    REP(10) { if (IN(10)) { unsigned char* ws = opq(A.ws); Gemm g{WSP(const bf16_t, WS_MERGED), WSP(const bf16_t, WS_WOUT), T, DM, DM, DM, DM}; StaticOrder S; S.init(T, DM, G, cidx);
        EpiResidN<1> E{opq(A.out), WSP(bf16_t, WS_X2B), WSP(bf16_t, WS_H), WSP(float, WS_SSP), WSP(const float, WS_MOD) + 1 * 3072 + 2048, WSP(const float, WS_AVEC) + 8 * 1024, 1.0f};
        gemm_phase<EpiResidN<1>, StaticOrder, true>(lds, g, S, E); } SEAM(10); }
    REP(12) { if (IN(12)) { unsigned char* ws = opq(A.ws); Gemm g{WSP(const bf16_t, WS_H), WSP(const bf16_t, WS_W13B), T, 2 * FF, DM, DM, DM}; StaticOrder S; S.init(T, 2 * FF, G, cidx);
        EpiSwiGLU E{WSP(bf16_t, WS_BIG), WSP(const float, WS_SSP), WSP(const float, WS_SHW2)}; gemm_phase<EpiSwiGLU, StaticOrder, true>(lds, g, S, E); } SEAM(12); }
    if (IN(13)) { unsigned char* ws = opq(A.ws); Gemm g{WSP(const bf16_t, WS_BIG), WSP(const bf16_t, WS_W2B), T, DM, FF, FF, FF}; StaticOrder S; S.init(T, DM, G, cidx);
        EpiResidN<2> E{WSP(const bf16_t, WS_X2B), opq(A.out), nullptr, nullptr, WSP(const float, WS_MOD) + 2 * 3072 + 2048, nullptr, 0.5f};
        gemm_phase<EpiResidN<2>, StaticOrder, true>(lds, g, S, E); }
#undef IN
#undef SEAM
#undef WSP
#undef REP
}

extern "C" void kernel_launch(void* const* d_in, const int* in_sizes, int n_in, void* d_out, int out_size, void* d_ws, size_t ws_size, hipStream_t stream) {
    static int grid = 0;
    if (grid == 0) {
        if (n_in != 20 || out_size != T * DM || ws_size < WS_END) { fprintf(stderr, "kernel_launch: unexpected shapes (n_in %d out %d ws %zu)\n", n_in, out_size, ws_size); grid = -1; return; }
        int dev = 0, cus = 0, per_cu = 0;
        hipGetDevice(&dev); hipDeviceGetAttribute(&cus, hipDeviceAttributeMultiprocessorCount, dev);
        if (hipFuncSetAttribute((const void*)fwd_kernel, hipFuncAttributeMaxDynamicSharedMemorySize, LDS_BYTES) != hipSuccess) { fprintf(stderr, "kernel_launch: hipFuncSetAttribute failed\n"); grid = -1; return; }
        if (hipOccupancyMaxActiveBlocksPerMultiprocessor(&per_cu, (const void*)fwd_kernel, 512, LDS_BYTES) != hipSuccess || per_cu < 1) per_cu = 1;
        (void)hipGetLastError();
        grid = cus * per_cu;
        if (grid > 256) grid = 256;
    }
    if (grid < 0) return;
    Args a{};
    for (int i = 0; i < 20; ++i) a.in[i] = d_in[i];
    a.out = (float*)d_out; a.ws = (unsigned char*)d_ws;
#if MK_PER_PHASE
    for (int p = 0; p < 14; ++p) { a.ph_lo = p; a.ph_hi = p + 1; hipLaunchKernelGGL(fwd_kernel, dim3(grid), dim3(512), LDS_BYTES, stream, a); }
#else
    a.ph_lo = 0; a.ph_hi = 14;
    void* args[] = {&a};
    hipError_t e = hipLaunchCooperativeKernel((const void*)fwd_kernel, dim3(grid), dim3(512), args, LDS_BYTES, stream);
    if (e != hipSuccess) fprintf(stderr, "cooperative launch failed: %s (grid %d)\n", hipGetErrorString(e), grid);
#endif
}
```
